# Optimizing an MI355X kernel written in HIP

```python
import jax, jax.numpy as jnp
from jax import lax
import numpy as np

D_MODEL = 2048
BATCH = 4
SEQ = 8192
DEPTH = 1

D_MIX = D_MODEL
CONV_CH = D_MIX // 4
N_HEADS = 12
HEAD_DIM = 128
N_KV = 3
GROUP = N_HEADS // N_KV
CONV_K = 31
CMP_BLOCK = 32
CMP_STRIDE = 16
CMP_HIDDEN = 256
SLC_BLOCK = 64
N_SELECT = 16
WINDOW = 512
Q_BLOCK = 64
D_FF = 5504
ROPE_THETA = 10000.0
EPS = 1e-6
N_IN = 2 * CONV_CH + N_HEADS * HEAD_DIM + 6 * N_KV * HEAD_DIM + 3 * N_HEADS

kernel_name = "hymba_conformer_conv_nsa_macaron"


def _split_points():
    sizes = [CONV_CH, CONV_CH, N_HEADS * HEAD_DIM] + [N_KV * HEAD_DIM] * 6 + [3 * N_HEADS]
    return [int(v) for v in np.cumsum(sizes)[:-1]]


def _rmsnorm(x, g):
    xf = x.astype(jnp.float32)
    y = xf * lax.rsqrt(jnp.mean(xf * xf, axis=-1, keepdims=True) + EPS)
    return (y * g.astype(jnp.float32)).astype(x.dtype)


def _layernorm(x, g, b):
    xf = x.astype(jnp.float32)
    mu = jnp.mean(xf, axis=-1, keepdims=True)
    xc = xf - mu
    var = jnp.mean(xc * xc, axis=-1, keepdims=True)
    return (xc * lax.rsqrt(var + EPS) * g.astype(jnp.float32) + b.astype(jnp.float32)).astype(x.dtype)


def _swiglu(h, w_gate, w_up, w_down):
    return (jax.nn.silu(h @ w_gate) * (h @ w_up)) @ w_down


def _rope_tables(seq):
    inv = jnp.power(ROPE_THETA, -jnp.arange(0, HEAD_DIM, 2, dtype=jnp.float32) / HEAD_DIM)
    ang = jnp.arange(seq, dtype=jnp.float32)[:, None] * inv[None, :]
    return jnp.cos(ang), jnp.sin(ang)


def _rope(x, cos, sin):
    xf = x.astype(jnp.float32)
    x1, x2 = jnp.split(xf, 2, axis=-1)
    c = cos[None, :, None, :]
    s = sin[None, :, None, :]
    return jnp.concatenate([x1 * c - x2 * s, x2 * c + x1 * s], axis=-1).astype(x.dtype)


def _masked_softmax(s, mask):
    s = jnp.where(mask, s, -jnp.inf)
    m = jnp.max(s, axis=-1, keepdims=True)
    m = jnp.where(jnp.isfinite(m), m, 0.0)
    e = jnp.where(mask, jnp.exp(s - m), 0.0)
    return e / jnp.maximum(jnp.sum(e, axis=-1, keepdims=True), 1e-30)


def _cmp_to_slc_matrix(n_cmp, n_slc):
    units_per_cmp = CMP_BLOCK // CMP_STRIDE
    units_per_slc = SLC_BLOCK // CMP_STRIDE
    first_unit = np.arange(n_cmp)[:, None]
    slc = np.arange(n_slc)[None, :]
    m = np.zeros((n_cmp, n_slc), np.float32)
    for u in range(units_per_cmp):
        m += ((first_unit + u) // units_per_slc == slc)
    return jnp.asarray(m)


def _conformer_conv(val, gate, dw_w, dw_b, ln_g, ln_b, pw_w):
    u = val * jax.nn.sigmoid(gate)
    u = lax.conv_general_dilated(
        u, dw_w[:, None, :].astype(u.dtype), window_strides=(1,),
        padding=[(CONV_K - 1, 0)], dimension_numbers=("NWC", "WIO", "NWC"),
        feature_group_count=CONV_CH) + dw_b
    u = _layernorm(u, ln_g, ln_b)
    return jax.nn.silu(u) @ pw_w


def _compress(kv, pos_emb, w1, w2):
    b, s = kv.shape[0], kv.shape[1]
    n_cmp = (s - CMP_BLOCK) // CMP_STRIDE + 1
    idx = np.arange(n_cmp)[:, None] * CMP_STRIDE + np.arange(CMP_BLOCK)[None, :]
    blk = kv[:, idx] + pos_emb[None, None, :, None, :]
    blk = blk.transpose(0, 3, 1, 2, 4).reshape(b, N_KV, n_cmp, CMP_BLOCK * HEAD_DIM)
    return jax.nn.silu(blk @ w1) @ w2


def _nsa(q, k_c, v_c, k_s, v_s, k_w, v_w, gate_logits, pos_k, pos_v, kw1, kw2, vw1, vw2):
    b, s = q.shape[0], q.shape[1]
    cos, sin = _rope_tables(s)
    k_cmp = _compress(k_c, pos_k, kw1, kw2)
    v_cmp = _compress(v_c, pos_v, vw1, vw2)
    n_cmp = k_cmp.shape[2]
    n_slc = s // SLC_BLOCK
    n_sel = min(N_SELECT, n_slc)
    q_raw = q.reshape(b, s, N_KV, GROUP, HEAD_DIM).transpose(0, 2, 3, 1, 4)
    q_rot = _rope(q, cos, sin).reshape(b, s, N_KV, GROUP, HEAD_DIM).transpose(0, 2, 3, 1, 4)
    k_sel = _rope(k_s, cos, sin).transpose(0, 2, 1, 3).reshape(b, N_KV, n_slc, SLC_BLOCK, HEAD_DIM)
    v_sel = v_s.transpose(0, 2, 1, 3).reshape(b, N_KV, n_slc, SLC_BLOCK, HEAD_DIM)
    pad = ((0, 0), (0, 0), (WINDOW, 0), (0, 0))
    k_win = jnp.pad(_rope(k_w, cos, sin).transpose(0, 2, 1, 3), pad)
    v_win = jnp.pad(v_w.transpose(0, 2, 1, 3), pad)
    gates = jax.nn.sigmoid(gate_logits.astype(jnp.float32)).reshape(
        b, s, N_KV, GROUP, 3).transpose(0, 2, 3, 1, 4)
    cmp_end = jnp.arange(n_cmp) * CMP_STRIDE + (CMP_BLOCK - 1)
    cmp_to_slc = _cmp_to_slc_matrix(n_cmp, n_slc)
    blk_ids = jnp.arange(n_slc)
    scale = HEAD_DIM ** -0.5
    gather_blocks = jax.vmap(jax.vmap(lambda blocks, ids: blocks[ids]))

    def block(i):
        q0 = i * Q_BLOCK
        t = q0 + jnp.arange(Q_BLOCK)
        qr = lax.dynamic_slice_in_dim(q_raw, q0, Q_BLOCK, axis=3)
        qp = lax.dynamic_slice_in_dim(q_rot, q0, Q_BLOCK, axis=3)
        g = lax.dynamic_slice_in_dim(gates, q0, Q_BLOCK, axis=3)
        sc = jnp.einsum("bgrqd,bgcd->bgrqc", qr, k_cmp, preferred_element_type=jnp.float32) * scale
        p_cmp = _masked_softmax(sc, cmp_end[None, :] <= t[:, None])
        o_cmp = jnp.einsum("bgrqc,bgcd->bgrqd", p_cmp.astype(v_cmp.dtype), v_cmp)
        imp = jnp.einsum("bgrqc,cs->bgqs", p_cmp, cmp_to_slc)
        jt = (t // SLC_BLOCK)[:, None]
        forced = (blk_ids == 0) | (blk_ids == jt) | (blk_ids == jt - 1)
        imp = jnp.where(forced, jnp.inf, jnp.where(blk_ids <= jt, imp, -jnp.inf))
        top_val, top_idx = lax.top_k(imp, n_sel)
        k_g = gather_blocks(k_sel, top_idx)
        v_g = gather_blocks(v_sel, top_idx)
        ss = jnp.einsum("bgrqd,bgqnkd->bgrqnk", qp, k_g, preferred_element_type=jnp.float32) * scale
        kpos = top_idx[..., None] * SLC_BLOCK + jnp.arange(SLC_BLOCK)
        ms = (kpos <= t[:, None, None]) & (top_val > -jnp.inf)[..., None]
        n_keys = n_sel * SLC_BLOCK
        p_slc = _masked_softmax(ss.reshape(b, N_KV, GROUP, Q_BLOCK, n_keys),
                                ms.reshape(b, N_KV, 1, Q_BLOCK, n_keys))
        o_slc = jnp.einsum("bgrqm,bgqmd->bgrqd", p_slc.astype(v_g.dtype),
                           v_g.reshape(b, N_KV, Q_BLOCK, n_keys, HEAD_DIM))
        kw = lax.dynamic_slice_in_dim(k_win, q0, WINDOW + Q_BLOCK, axis=2)
        vw = lax.dynamic_slice_in_dim(v_win, q0, WINDOW + Q_BLOCK, axis=2)
        kp = q0 - WINDOW + jnp.arange(WINDOW + Q_BLOCK)
        mw = (kp[None, :] <= t[:, None]) & (kp[None, :] > t[:, None] - WINDOW) & (kp[None, :] >= 0)
        sw = jnp.einsum("bgrqd,bgkd->bgrqk", qp, kw, preferred_element_type=jnp.float32) * scale
        p_win = _masked_softmax(sw, mw)
        o_win = jnp.einsum("bgrqk,bgkd->bgrqd", p_win.astype(vw.dtype), vw)
        o = g[..., 0:1] * o_cmp + g[..., 1:2] * o_slc + g[..., 2:3] * o_win
        return o.astype(q.dtype)

    out = lax.map(block, jnp.arange(s // Q_BLOCK))
    return out.transpose(1, 0, 4, 2, 3, 5).reshape(b, s, N_HEADS * HEAD_DIM)


def setup_inputs(seed: int = 0) -> dict:
    key = jax.random.key(seed)
    ks = iter(jax.random.split(key, 32))
    f32 = jnp.float32
    L = DEPTH

    def w(shape, fan_in):
        return jax.random.normal(next(ks), shape, f32) * fan_in ** -0.5

    def gain(shape):
        return 1.0 + 0.02 * jax.random.normal(next(ks), shape, f32)

    def small(shape, sc=0.02):
        return sc * jax.random.normal(next(ks), shape, f32)

    return {
        "x": jax.random.normal(next(ks), (BATCH, SEQ, D_MODEL), f32),
        "ffn1_norm": gain((L, D_MODEL)),
        "ffn1_w_gate": w((L, D_MODEL, D_FF), D_MODEL),
        "ffn1_w_up": w((L, D_MODEL, D_FF), D_MODEL),
        "ffn1_w_down": w((L, D_FF, D_MODEL), D_FF),
        "mix_norm": gain((L, D_MODEL)),
        "w_in": w((L, D_MODEL, N_IN), D_MODEL),
        "cmp_pos_k": small((L, CMP_BLOCK, HEAD_DIM), 0.1),
        "cmp_pos_v": small((L, CMP_BLOCK, HEAD_DIM), 0.1),
        "cmp_k_w1": w((L, CMP_BLOCK * HEAD_DIM, CMP_HIDDEN), CMP_BLOCK * HEAD_DIM),
        "cmp_k_w2": w((L, CMP_HIDDEN, HEAD_DIM), CMP_HIDDEN),
        "cmp_v_w1": w((L, CMP_BLOCK * HEAD_DIM, CMP_HIDDEN), CMP_BLOCK * HEAD_DIM),
        "cmp_v_w2": w((L, CMP_HIDDEN, HEAD_DIM), CMP_HIDDEN),
        "conv_dw_w": w((L, CONV_K, CONV_CH), CONV_K),
        "conv_dw_b": small((L, CONV_CH)),
        "conv_ln_g": gain((L, CONV_CH)),
        "conv_ln_b": small((L, CONV_CH)),
        "conv_pw_w": w((L, CONV_CH, CONV_CH), CONV_CH),
        "out_norm_conv": gain((L, CONV_CH)),
        "out_norm_nsa": gain((L, N_HEADS * HEAD_DIM)),
        "w_out": w((L, D_MIX, D_MODEL), D_MIX),
        "ffn2_norm": gain((L, D_MODEL)),
        "ffn2_w_gate": w((L, D_MODEL, D_FF), D_MODEL),
        "ffn2_w_up": w((L, D_MODEL, D_FF), D_MODEL),
        "ffn2_w_down": w((L, D_FF, D_MODEL), D_FF),
        "final_norm": gain((D_MODEL,)),
    }


def reference(x, ffn1_norm, ffn1_w_gate, ffn1_w_up, ffn1_w_down, mix_norm, w_in,
              cmp_pos_k, cmp_pos_v, cmp_k_w1, cmp_k_w2, cmp_v_w1, cmp_v_w2,
              conv_dw_w, conv_dw_b, conv_ln_g, conv_ln_b, conv_pw_w,
              out_norm_conv, out_norm_nsa, w_out,
              ffn2_norm, ffn2_w_gate, ffn2_w_up, ffn2_w_down, final_norm):
    b, s = x.shape[0], x.shape[1]
    splits = _split_points()
    for l in range(DEPTH):
        h = _rmsnorm(x, ffn1_norm[l])
        x = x + 0.5 * _swiglu(h, ffn1_w_gate[l], ffn1_w_up[l], ffn1_w_down[l])
        h = _rmsnorm(x, mix_norm[l])
        proj = h @ w_in[l]
        c_val, c_gate, q, k_c, v_c, k_s, v_s, k_w, v_w, g_logit = jnp.split(proj, splits, axis=-1)
        conv_out = _conformer_conv(c_val, c_gate, conv_dw_w[l], conv_dw_b[l],
                                   conv_ln_g[l], conv_ln_b[l], conv_pw_w[l])
        kvs = lambda a: a.reshape(b, s, N_KV, HEAD_DIM)
        attn_out = _nsa(q.reshape(b, s, N_HEADS, HEAD_DIM), kvs(k_c), kvs(v_c), kvs(k_s), kvs(v_s),
                        kvs(k_w), kvs(v_w), g_logit, cmp_pos_k[l], cmp_pos_v[l],
                        cmp_k_w1[l], cmp_k_w2[l], cmp_v_w1[l], cmp_v_w2[l])
        mixed = jnp.concatenate([_rmsnorm(conv_out, out_norm_conv[l]),
                                 _rmsnorm(attn_out, out_norm_nsa[l])], axis=-1)
        x = x + mixed @ w_out[l]
        h = _rmsnorm(x, ffn2_norm[l])
        x = x + 0.5 * _swiglu(h, ffn2_w_gate[l], ffn2_w_up[l], ffn2_w_down[l])
    return _rmsnorm(x, final_norm)
```

```cpp
#include <hip/hip_runtime.h>
#include <hip/hip_bf16.h>
#include <cstdio>
#include <cstdint>

#ifndef OUT_FP8
#define OUT_FP8 1
#endif
#ifndef MK_N_LAUNCHES
#define MK_N_LAUNCHES 1
#endif

#define GAS __attribute__((address_space(1)))
#define LAS __attribute__((address_space(3)))
typedef unsigned short bf16_t;
typedef short bf16x8 __attribute__((ext_vector_type(8)));
typedef short s16x4 __attribute__((ext_vector_type(4)));
typedef float f32x4 __attribute__((ext_vector_type(4)));
typedef float f32x2 __attribute__((ext_vector_type(2)));
typedef float f32x16 __attribute__((ext_vector_type(16)));
typedef unsigned u32x4 __attribute__((ext_vector_type(4)));
typedef unsigned u32x2 __attribute__((ext_vector_type(2)));

constexpr int BATCH = 4, SEQ = 8192, DM = 2048, T = BATCH * SEQ, FF = 5504, NH = 12, HD = 128, NKV = 3, CCH = 512, NIN = 4900;
constexpr int FFP = 5632;
constexpr float W8S = 64.f, W8S_INV = 1.f / 64.f;
constexpr float SW8 = 127.f * 45.254833995939045f / 5.5f, SW8_INV = 1.f / SW8, SA1 = 127.f / 5.75f, SA2 = 127.f / 8.f;
constexpr float A8C = 8.f, A8N = 16.f;
constexpr int NCP = 512;
constexpr int NWIN = 20 * 256;
constexpr float EPS = 1e-6f;
constexpr float SSX = 4096.f, SSX_INV = 1.f / 4096.f;
constexpr float SSC = 65536.f, SSC_INV = 1.f / 65536.f;
constexpr float SSN = 262144.f, SSN_INV = 1.f / 262144.f;

constexpr size_t MiB = 1u << 20;
constexpr size_t WS_CTL = 0, CTL_ZERO_BYTES = 2 * MiB;
constexpr size_t WS_SS1 = 1 * MiB, WS_SS2 = WS_SS1 + 131072, WS_SS3 = WS_SS2 + 131072, WS_SSC = WS_SS3 + 131072, WS_SSN = WS_SSC + 131072;
constexpr size_t WS_SS0 = 2 * MiB, WS_B1 = 2 * MiB + 262144, WS_ROWF = 2 * MiB + 524288;
constexpr size_t WS_WGU1 = 8 * MiB, WS_WD1 = 30 * MiB, WS_WGU2 = 41 * MiB, WS_WD2 = 63 * MiB;
constexpr size_t WS_XB8 = 74 * MiB;
constexpr size_t WS_WIN = 138 * MiB, WS_WOUT = 158 * MiB, WS_WC1 = 166 * MiB, WS_WPW = 170 * MiB;
constexpr size_t WS_XB = 172 * MiB;
constexpr size_t WS_ACT = 300 * MiB;
constexpr size_t WS_QRAW = 300 * MiB, WS_QROT = 396 * MiB, WS_KC = 492 * MiB, WS_VC = 517 * MiB, WS_KS = 542 * MiB, WS_VS = 566 * MiB, WS_KW = 590 * MiB, WS_VW = 614 * MiB;
constexpr size_t WS_U = 638 * MiB, WS_S1 = 670 * MiB, WS_G = 702 * MiB, WS_MIXED = 708 * MiB, WS_CMPP = 836 * MiB, WS_KCMP = 884 * MiB, WS_VCMP = 886 * MiB;
constexpr size_t WS_VTS = 396 * MiB, WS_VTW = 408 * MiB;
constexpr size_t WS_END = 888 * MiB;
constexpr int GLD = 40;

constexpr int CW_BAR = 4096;

constexpr int RING_BYTES = 131072;
constexpr int LDSCTL_OFF = 143360 - 1024, MISC_OFF = LDSCTL_OFF + 320;
constexpr int LDS_BYTES = 147456;
constexpr int NWAVES = 8;

#define LDS_WAIT() asm volatile("s_waitcnt lgkmcnt(0)" ::: "memory")
#define VM_WAIT() asm volatile("s_waitcnt vmcnt(0)" ::: "memory")
#define SBAR() __builtin_amdgcn_sched_barrier(0)

__device__ __forceinline__ int lane_id_() { int l; asm volatile("v_mbcnt_lo_u32_b32 %0, -1, 0\n\tv_mbcnt_hi_u32_b32 %0, -1, %0" : "=v"(l)); return l; }
__device__ __forceinline__ unsigned cvtpk(float lo, float hi) { unsigned r; asm volatile("v_cvt_pk_bf16_f32 %0, %1, %2" : "=v"(r) : "v"(lo), "v"(hi)); return r; }
__device__ __forceinline__ float clamp448(float v) { return __builtin_amdgcn_fmed3f(v, -448.f, 448.f); }
__device__ __forceinline__ u32x2 pk8_fp8(const float* v) {
    unsigned w0 = 0u, w1 = 0u;
    w0 = __builtin_amdgcn_cvt_pk_fp8_f32(clamp448(v[0]), clamp448(v[1]), w0, false); w0 = __builtin_amdgcn_cvt_pk_fp8_f32(clamp448(v[2]), clamp448(v[3]), w0, true);
    w1 = __builtin_amdgcn_cvt_pk_fp8_f32(clamp448(v[4]), clamp448(v[5]), w1, false); w1 = __builtin_amdgcn_cvt_pk_fp8_f32(clamp448(v[6]), clamp448(v[7]), w1, true);
    return (u32x2){w0, w1};
}
__device__ __forceinline__ u32x2 pk8_i8(const float* v, float scale) {
    unsigned t[8];
#pragma unroll
    for (int j = 0; j < 8; ++j) t[j] = __float_as_uint(__builtin_amdgcn_fmed3f(v[j] * scale, -127.f, 127.f) + 12582912.f);
    const unsigned lo = __builtin_amdgcn_perm(__builtin_amdgcn_perm(t[3], t[2], 0x0c0c0400u) << 16, __builtin_amdgcn_perm(t[1], t[0], 0x0c0c0400u), 0x07060100u);
    const unsigned hi = __builtin_amdgcn_perm(__builtin_amdgcn_perm(t[7], t[6], 0x0c0c0400u) << 16, __builtin_amdgcn_perm(t[5], t[4], 0x0c0c0400u), 0x07060100u);
    return (u32x2){lo, hi};
}
__device__ __forceinline__ float bf2f(unsigned short h) { return __uint_as_float((unsigned)h << 16); }
__device__ __forceinline__ float bflo(unsigned w) { return __uint_as_float(w << 16); }
__device__ __forceinline__ float bfhi(unsigned w) { return __uint_as_float(w & 0xffff0000u); }
__device__ __forceinline__ float wave_sum(float v) {
    v += __builtin_bit_cast(float, __builtin_amdgcn_update_dpp(0, __builtin_bit_cast(int, v), 0xB1, 0xF, 0xF, true));
    v += __builtin_bit_cast(float, __builtin_amdgcn_update_dpp(0, __builtin_bit_cast(int, v), 0x4E, 0xF, 0xF, true));
    v += __builtin_bit_cast(float, __builtin_amdgcn_update_dpp(0, __builtin_bit_cast(int, v), 0x141, 0xF, 0xF, true));
    v += __builtin_bit_cast(float, __builtin_amdgcn_update_dpp(0, __builtin_bit_cast(int, v), 0x140, 0xF, 0xF, true));
    { auto rr = __builtin_amdgcn_permlane16_swap(__float_as_uint(v), __float_as_uint(v), false, false); v = __uint_as_float(rr[0]) + __uint_as_float(rr[1]); }
    { auto rr = __builtin_amdgcn_permlane32_swap(__float_as_uint(v), __float_as_uint(v), false, false); v = __uint_as_float(rr[0]) + __uint_as_float(rr[1]); }
    return v;
}
template <int CTRL> __device__ __forceinline__ float dppf(float v) { return __builtin_bit_cast(float, __builtin_amdgcn_update_dpp(0, __builtin_bit_cast(int, v), CTRL, 0xF, 0xF, true)); }
template <int CTRL> __device__ __forceinline__ unsigned dppu(unsigned v) { return (unsigned)__builtin_amdgcn_update_dpp(0, (int)v, CTRL, 0xF, 0xF, true); }
#define DPP_X1 0xB1
#define DPP_X2 0x4E
#define DPP_HM 0x141
#define DPP_RM 0x140
__device__ __forceinline__ float sigmoidf_(float v) { return __builtin_amdgcn_rcpf(1.f + __builtin_amdgcn_exp2f(-1.4426950408889634f * v)); }
__device__ __forceinline__ float siluf_(float v) { return v * sigmoidf_(v); }
__device__ __forceinline__ float rs_from(unsigned ss, float inv_scale, float inv_n) { return __builtin_amdgcn_rsqf((float)ss * (inv_scale * inv_n) + EPS); }
__device__ __forceinline__ unsigned fixu(float v, float scale) { return (unsigned)(v * scale + 0.5f); }

namespace pg8 {
constexpr int BM = 256, BK = 64, HALF = 128, HTB = HALF * BK * 2, NXCD = 8, WGM = 4;
__host__ __device__ __forceinline__ int lds_byte(int r, int c) { const int st = (r >> 4) * 2 + (c >> 5), rr = r & 15, cc = c & 31, ob = rr * 64 + cc * 2; return st * 1024 + (ob ^ (((ob >> 9) & 1) << 5)); }
__host__ __device__ __forceinline__ void stage_rc(int b, int& R, int& C) { const int st = b / 1024, sb = b % 1024, swz = sb ^ (((sb >> 9) & 1) << 5); R = (st >> 1) * 16 + swz / 64; C = (st & 1) * 32 + (swz % 64) / 2; }
__host__ __device__ __forceinline__ int perm32(int rho) { const int n = rho >> 4, i = rho & 15; return 8 * (i >> 2) + 4 * n + (i & 3); }

typedef int i32x8 __attribute__((ext_vector_type(8)));
typedef int i32x4 __attribute__((ext_vector_type(4)));
typedef short s16x16 __attribute__((ext_vector_type(16)));
__device__ __forceinline__ i32x8 cat8(bf16x8 a, bf16x8 b) { return __builtin_bit_cast(i32x8, __builtin_shufflevector(a, b, 0, 1, 2, 3, 4, 5, 6, 7, 8, 9, 10, 11, 12, 13, 14, 15)); }
__device__ __forceinline__ bf16x8 lo8(i32x8 v) { return __builtin_bit_cast(bf16x8, __builtin_shufflevector(v, v, 0, 1, 2, 3)); }
__device__ __forceinline__ bf16x8 hi8(i32x8 v) { return __builtin_bit_cast(bf16x8, __builtin_shufflevector(v, v, 4, 5, 6, 7)); }
struct Unit { int pm, pn; long ao, bo; int aux; };
struct Gemm { const bf16_t* A; const bf16_t* Bt; int K, lda, ldb; };

struct StaticOrder {
    int nM, nN, nwg, G, c; long ta, tb;
    __device__ void init(int M, int N, int G_, int c_, int lda, int ldb) { nM = M / BM; nN = N / BM; nwg = nM * nN; G = G_; c = c_; ta = (long)BM * lda * 2; tb = (long)BM * ldb * 2; }
    __device__ bool next(int i, Unit& u) const {
        const long L = (long)i * G + c; if (L >= nwg) return false;
        int wgid = (int)L; { const int q = nwg / NXCD, r = nwg % NXCD, xcd = wgid % NXCD, off = wgid / NXCD; wgid = (xcd < r ? xcd * (q + 1) : r * (q + 1) + (xcd - r) * q) + off; }
        const int nig = WGM * nN, gid = wgid / nig, fm = gid * WGM, gsz = (nM - fm) < WGM ? (nM - fm) : WGM;
        u.pm = fm + ((wgid % nig) % gsz); u.pn = (wgid % nig) / gsz; u.ao = u.pm * ta; u.bo = u.pn * tb; u.aux = 0; return true;
    }
    __device__ __forceinline__ void a_ready(const Unit&) const {}
    __device__ __forceinline__ void done(const Unit&) const {}
};

template <class Epi, class Sched, bool ALIGN_EPI = false, int PREC = 0>
__device__ __forceinline__ void gemm_phase(LAS unsigned char* lds, const Gemm g, const Sched& S, const Epi& E, int wid) {
    const int lane = lane_id_(), tid = wid * 64 + lane, wr = wid >> 2, wc = wid & 3, fr = lane & 15, fq = lane >> 4;
    const int K = g.K, nt = K / BK;
    unsigned voffA[2], voffB[2];
#pragma unroll
    for (int i = 0; i < 2; ++i) { int R, C; stage_rc(tid * 16 + i * 8192, R, C); const int Rb = (R & ~31) + perm32(R & 31);
        voffA[i] = (unsigned)(R * g.lda + C) * 2u; voffB[i] = (unsigned)(Rb * g.ldb + C) * 2u; }
    const size_t kstep = (size_t)(BK * 2);
    const size_t hstepA = (size_t)HALF * g.lda * 2, hstepB = (size_t)HALF * g.ldb * 2;
    const unsigned ldsw = (unsigned)wid * 1024u;
    const int aoff = lds_byte(wr * 64 + fr, fq * 8), boff = lds_byte(wc * 32 + fr, fq * 8);
#define PG8_SA(b, h) (((b) * 2 + (h)) * HTB)
#define PG8_SB(b, h) ((4 + (b) * 2 + (h)) * HTB)
#define PG8_STAGE(bufoff, gbase, voff) do { _Pragma("unroll") for (int _i = 0; _i < 2; ++_i) \
        __builtin_amdgcn_global_load_lds((const unsigned*)((const char*)(gbase) + (voff)[_i]), (LAS unsigned*)(lds + (bufoff) + ldsw + _i * 8192), 16, 0, 0); } while (0)
#define PG8_LDA(dst, b, h) do { _Pragma("unroll") for (int m = 0; m < 4; ++m) { const bf16x8 f0_ = *(const LAS bf16x8*)(lds + PG8_SA(b, h) + aoff + m * 2048), f1_ = *(const LAS bf16x8*)(lds + PG8_SA(b, h) + aoff + m * 2048 + 1024); dst[m] = cat8(f0_, f1_); } } while (0)
#define PG8_LDB(dst, b, h) do { _Pragma("unroll") for (int n = 0; n < 2; ++n) { const bf16x8 f0_ = *(const LAS bf16x8*)(lds + PG8_SB(b, h) + boff + n * 2048), f1_ = *(const LAS bf16x8*)(lds + PG8_SB(b, h) + boff + n * 2048 + 1024); dst[n] = cat8(f0_, f1_); } } while (0)
#define PG8_MMA(ai, bj, At, Bt) do { __builtin_amdgcn_s_setprio(1); _Pragma("unroll") for (int m = 0; m < 4; ++m) _Pragma("unroll") for (int n = 0; n < 2; ++n) { \
        if constexpr (PREC == 1) { asm volatile("v_mfma_scale_f32_16x16x128_f8f6f4 %0, %1, %2, %0, %3, %3 op_sel_hi:[0,0,0]" : "+v"(acc[ai][bj][m][n]) : "v"(Bt[n]), "v"(At[m]), "v"(sc1)); } \
        else if constexpr (PREC == 2) { i32x4 c_ = __builtin_bit_cast(i32x4, acc[ai][bj][m][n]); \
               c_ = __builtin_amdgcn_mfma_i32_16x16x64_i8(__builtin_bit_cast(i32x4, lo8(Bt[n])), __builtin_bit_cast(i32x4, lo8(At[m])), c_, 0, 0, 0); \
               c_ = __builtin_amdgcn_mfma_i32_16x16x64_i8(__builtin_bit_cast(i32x4, hi8(Bt[n])), __builtin_bit_cast(i32x4, hi8(At[m])), c_, 0, 0, 0); acc[ai][bj][m][n] = __builtin_bit_cast(f32x4, c_); } \
        else { acc[ai][bj][m][n] = __builtin_amdgcn_mfma_f32_16x16x32_bf16(lo8(Bt[n]), lo8(At[m]), acc[ai][bj][m][n], 0, 0, 0); \
               acc[ai][bj][m][n] = __builtin_amdgcn_mfma_f32_16x16x32_bf16(hi8(Bt[n]), hi8(At[m]), acc[ai][bj][m][n], 0, 0, 0); } } \
        __builtin_amdgcn_s_setprio(0); } while (0)
#define PG8_WAIT_V(n) asm volatile("s_waitcnt vmcnt(" #n ")" ::: "memory")
#define PG8_WAIT_L(n) asm volatile("s_waitcnt lgkmcnt(" #n ")" ::: "memory")
#define PG8_BAR __builtin_amdgcn_s_barrier()
#define PG8_SCHED __builtin_amdgcn_sched_barrier(0)
    Unit cur, nxt; int ui = 0;
    if (!S.next(0, cur)) return;
    f32x4 acc[2][2][4][2];
#pragma unroll
    for (int a = 0; a < 2; ++a)
#pragma unroll
        for (int b = 0; b < 2; ++b)
#pragma unroll
            for (int m = 0; m < 4; ++m)
#pragma unroll
                for (int n = 0; n < 2; ++n) acc[a][b][m][n] = (f32x4){0.f, 0.f, 0.f, 0.f};
    i32x8 At[4], B0[2], B1[2]; const unsigned sc1 = 0x7f7f7f7fu;
    const char* cA = (const char*)g.A + cur.ao; const char* cB = (const char*)g.Bt + cur.bo;
    S.a_ready(cur);
    PG8_STAGE(PG8_SB(0, 0), cB, voffB); PG8_STAGE(PG8_SB(0, 1), cB + hstepB, voffB); PG8_STAGE(PG8_SA(0, 0), cA, voffA); PG8_STAGE(PG8_SA(0, 1), cA + hstepA, voffA);
    if (wr == 1) PG8_BAR;
    PG8_WAIT_V(2); PG8_BAR;
    PG8_STAGE(PG8_SB(1, 0), cB + kstep, voffB); PG8_STAGE(PG8_SA(1, 0), cA + kstep, voffA); PG8_STAGE(PG8_SB(1, 1), cB + hstepB + kstep, voffB);
    PG8_WAIT_V(6); PG8_BAR;
    for (;;) {
        const bool has_next = S.next(ui + 1, nxt);
        const char* nA = has_next ? (const char*)g.A + nxt.ao : cA; const char* nB = has_next ? (const char*)g.Bt + nxt.bo : cB;
        int tb = 0;
#pragma unroll 1
        for (int seg = 0; seg < (Epi::MID_TILE > 0 ? 2 : 1); ++seg) {
        const int te = (Epi::MID_TILE > 0 && seg == 0) ? Epi::MID_TILE : nt;
        if constexpr (Epi::MID_TILE > 0) { if (seg == 1) { PG8_SCHED; E.mid(acc, cur, wr, fr); PG8_SCHED; } }
#pragma unroll 1
        for (int t = tb; t < te; t += 2) {
            const bool last = (t == nt - 2);
            const char* a1 = cA + (size_t)(t + 1) * kstep;
            const char* a2 = last ? nA : cA + (size_t)(t + 2) * kstep; const char* b2 = last ? nB : cB + (size_t)(t + 2) * kstep;
            const char* a3 = a2 + kstep; const char* b3 = b2 + kstep;
            if (last && has_next) S.a_ready(nxt);
            PG8_LDB(B0, 0, 0); PG8_LDB(B1, 0, 1); PG8_SCHED; PG8_LDA(At, 0, 0); PG8_STAGE(PG8_SA(1, 1), a1 + hstepA, voffA);
            PG8_WAIT_V(8); PG8_WAIT_L(0); PG8_BAR; PG8_MMA(0, 0, At, B0); PG8_MMA(0, 1, At, B1); PG8_BAR; PG8_SCHED;
            PG8_LDA(At, 0, 1); PG8_STAGE(PG8_SB(0, 0), b2, voffB); PG8_STAGE(PG8_SB(0, 1), b2 + hstepB, voffB); PG8_STAGE(PG8_SA(0, 0), a2, voffA);
            PG8_WAIT_V(8); PG8_WAIT_L(0); PG8_BAR; PG8_MMA(1, 0, At, B0); PG8_MMA(1, 1, At, B1); PG8_BAR; PG8_SCHED;
            PG8_LDB(B0, 1, 0); PG8_LDB(B1, 1, 1); PG8_SCHED; PG8_LDA(At, 1, 0); PG8_STAGE(PG8_SA(0, 1), a2 + hstepA, voffA);
            PG8_WAIT_V(8); PG8_WAIT_L(0); PG8_BAR; PG8_MMA(0, 0, At, B0); PG8_MMA(0, 1, At, B1); PG8_BAR; PG8_SCHED;
            PG8_LDA(At, 1, 1); PG8_STAGE(PG8_SB(1, 0), b3, voffB); PG8_STAGE(PG8_SB(1, 1), b3 + hstepB, voffB); PG8_STAGE(PG8_SA(1, 0), a3, voffA);
            PG8_WAIT_V(8); PG8_WAIT_L(0); PG8_BAR; PG8_MMA(1, 0, At, B0); PG8_MMA(1, 1, At, B1); PG8_BAR; PG8_SCHED;
        }
        tb = te;
        }
        if constexpr (ALIGN_EPI) { if (wr == 0) PG8_BAR; }
        if constexpr (PREC == 1) asm volatile("s_nop 15\n\ts_nop 15" ::: "memory");
        if constexpr (PREC == 2) {
#pragma unroll
            for (int a = 0; a < 2; ++a)
#pragma unroll
                for (int b = 0; b < 2; ++b)
#pragma unroll
                    for (int m = 0; m < 4; ++m)
#pragma unroll
                        for (int n = 0; n < 2; ++n) acc[a][b][m][n] = __builtin_convertvector(__builtin_bit_cast(i32x4, acc[a][b][m][n]), f32x4); }
        E(acc, cur, wr, wc, fr, fq); S.done(cur);
        if (!has_next) break;
#pragma unroll
        for (int a = 0; a < 2; ++a)
#pragma unroll
            for (int b = 0; b < 2; ++b)
#pragma unroll
                for (int m = 0; m < 4; ++m)
#pragma unroll
                    for (int n = 0; n < 2; ++n) acc[a][b][m][n] = (f32x4){0.f, 0.f, 0.f, 0.f};
        cur = nxt; cA = nA; cB = nB; ++ui;
        if constexpr (ALIGN_EPI) { if (wr == 1) PG8_BAR; }
    }
    PG8_WAIT_V(0);
    if constexpr (!ALIGN_EPI) { if (wr == 0) PG8_BAR; }
    PG8_BAR;
#undef PG8_SA
#undef PG8_SB
#undef PG8_STAGE
#undef PG8_LDA
#undef PG8_LDB
#undef PG8_MMA
#undef PG8_WAIT_V
#undef PG8_WAIT_L
#undef PG8_BAR
#undef PG8_SCHED
}

typedef const f32x4 (&AccRef)[2][2][4][2];

struct EpiSwiGLU {
    static constexpr int MID_TILE = 0;
    unsigned char* O; const unsigned* ss; const float* rowf; float cf;
    __device__ __forceinline__ void mid(f32x4 (&)[2][2][4][2], const Unit&, int, int) const {}
    __device__ __forceinline__ void operator()(AccRef acc, const Unit& u, int wr, int wc, int fr, int fq) const {
        int row0 = u.pm * BM + wr * 64 + fr; asm volatile("" : "+v"(row0)); const int col0 = u.pn * 128 + wc * 32 + 8 * fq;
        unsigned sv[8];
#pragma unroll
        for (int q = 0; q < 8; ++q) sv[q] = ss[row0 + (q >> 2) * HALF + (q & 3) * 16];
        asm volatile("" ::: "memory");
#pragma unroll
        for (int ai = 0; ai < 2; ++ai)
#pragma unroll
            for (int m = 0; m < 4; ++m) { const int row = row0 + ai * HALF + m * 16; const float r = rs_from(sv[ai * 4 + m], SSX_INV, 1.f / DM) * cf * (rowf ? rowf[row] : 1.f);
                float o[8];
#pragma unroll
                for (int n = 0; n < 2; ++n)
#pragma unroll
                    for (int e = 0; e < 4; ++e) { const float gv = acc[ai][0][m][n][e] * r, uv = acc[ai][1][m][n][e] * r; o[4 * n + e] = siluf_(gv) * uv; }
                *(u32x2*)(O + (size_t)row * FFP + col0) = pk8_fp8(o); }
    }
};

template <int MODE> struct EpiResid {
    static constexpr int MID_TILE = MODE == 1 ? (OUT_FP8 ? CCH / 128 : CCH / BK) : 0;
    const float* xf; bf16_t* xb; unsigned char* x8; unsigned* ss; const unsigned* ssc; const unsigned* ssn;
    __device__ __forceinline__ void mid(f32x4 (&acc)[2][2][4][2], const Unit& u, int wr, int fr) const {
        if constexpr (MODE == 1) {
            int row0 = u.pm * BM + wr * 64 + fr; asm volatile("" : "+v"(row0));
#pragma unroll
            for (int ai = 0; ai < 2; ++ai)
#pragma unroll
                for (int m = 0; m < 4; ++m) { const int row = row0 + ai * HALF + m * 16;
                    const float f = rs_from(ssc[row], SSC_INV, 1.f / CCH) * __builtin_amdgcn_sqrtf((float)ssn[row] * (SSN_INV / (NH * HD)) + EPS) * (OUT_FP8 ? A8N / A8C : 1.f);
#pragma unroll
                    for (int bj = 0; bj < 2; ++bj)
#pragma unroll
                        for (int n = 0; n < 2; ++n) acc[ai][bj][m][n] *= f;
                    __builtin_amdgcn_sched_barrier(0); }
        }
    }
    __device__ __forceinline__ void operator()(AccRef acc, const Unit& u, int wr, int wc, int fr, int fq) const {
        int row0 = u.pm * BM + wr * 64 + fr; asm volatile("" : "+v"(row0)); const int col0 = u.pn * BM + wc * 32 + 8 * fq;
#pragma unroll
        for (int ai = 0; ai < 2; ++ai) {
            f32x4 xv[4][2][2]; float scv[4];
#pragma unroll
            for (int m = 0; m < 4; ++m) { const int row = row0 + ai * HALF + m * 16;
                scv[m] = W8S_INV; if constexpr (MODE == 1) scv[m] = rs_from(ssn[row], SSN_INV, 1.f / (NH * HD)) * (OUT_FP8 ? W8S_INV / A8N : 1.f);
#pragma unroll
                for (int bj = 0; bj < 2; ++bj) { const size_t idx = (size_t)row * DM + col0 + bj * HALF;
                    if constexpr (MODE == 0) { xv[m][bj][0] = *(const f32x4*)(xf + idx); xv[m][bj][1] = *(const f32x4*)(xf + idx + 4); }
                    else { const u32x4 w = *(const u32x4*)(xb + idx); xv[m][bj][0] = (f32x4){bflo(w.x), bfhi(w.x), bflo(w.y), bfhi(w.y)}; xv[m][bj][1] = (f32x4){bflo(w.z), bfhi(w.z), bflo(w.w), bfhi(w.w)}; } } }
            asm volatile("" ::: "memory");
#pragma unroll
            for (int m = 0; m < 4; ++m) { const int row = row0 + ai * HALF + m * 16; const float sc = scv[m];
                float sq = 0.f;
#pragma unroll
                for (int bj = 0; bj < 2; ++bj) { const size_t idx = (size_t)row * DM + col0 + bj * HALF;
                    const f32x4 y0 = xv[m][bj][0] + acc[ai][bj][m][0] * sc, y1 = xv[m][bj][1] + acc[ai][bj][m][1] * sc;
                    { u32x4 w; w.x = cvtpk(y0[0], y0[1]); w.y = cvtpk(y0[2], y0[3]); w.z = cvtpk(y1[0], y1[1]); w.w = cvtpk(y1[2], y1[3]); *(u32x4*)(xb + idx) = w; }
                    if constexpr (MODE != 2) { const float yv[8] = {y0[0], y0[1], y0[2], y0[3], y1[0], y1[1], y1[2], y1[3]}; *(u32x2*)(x8 + idx) = pk8_i8(yv, MODE == 0 ? SA1 : SA2); }
                    sq += (y0[0] * y0[0] + y0[1] * y0[1]) + (y0[2] * y0[2] + y0[3] * y0[3]) + (y1[0] * y1[0] + y1[1] * y1[1]) + (y1[2] * y1[2] + y1[3] * y1[3]); }
                sq += __shfl_xor(sq, 16); sq += __shfl_xor(sq, 32);
                if (fq == 0) atomicAdd(ss + row, fixu(sq, SSX)); }
        }
    }
};

struct EpiPw {
    static constexpr int MID_TILE = 0;
    void* O; unsigned* ssc;
    __device__ __forceinline__ void mid(f32x4 (&)[2][2][4][2], const Unit&, int, int) const {}
    __device__ __forceinline__ void operator()(AccRef acc, const Unit& u, int wr, int wc, int fr, int fq) const {
        int row0 = u.pm * BM + wr * 64 + fr; asm volatile("" : "+v"(row0)); const int col0 = u.pn * BM + wc * 32 + 8 * fq;
#pragma unroll
        for (int ai = 0; ai < 2; ++ai)
#pragma unroll
            for (int m = 0; m < 4; ++m) { const int row = row0 + ai * HALF + m * 16; float sq = 0.f;
#pragma unroll
                for (int bj = 0; bj < 2; ++bj) { const f32x4 y0 = acc[ai][bj][m][0], y1 = acc[ai][bj][m][1];
                    if constexpr (OUT_FP8) { const float yv[8] = {y0[0] * A8C, y0[1] * A8C, y0[2] * A8C, y0[3] * A8C, y1[0] * A8C, y1[1] * A8C, y1[2] * A8C, y1[3] * A8C};
                        *(u32x2*)((unsigned char*)O + (size_t)row * DM + col0 + bj * HALF) = pk8_fp8(yv); }
                    else { u32x4 w; w.x = cvtpk(y0[0], y0[1]); w.y = cvtpk(y0[2], y0[3]); w.z = cvtpk(y1[0], y1[1]); w.w = cvtpk(y1[2], y1[3]);
                        *(u32x4*)((bf16_t*)O + (size_t)row * DM + col0 + bj * HALF) = w; }
                    sq += (y0[0] * y0[0] + y0[1] * y0[1]) + (y0[2] * y0[2] + y0[3] * y0[3]) + (y1[0] * y1[0] + y1[1] * y1[1]) + (y1[2] * y1[2] + y1[3] * y1[3]); }
                sq += __shfl_xor(sq, 16); sq += __shfl_xor(sq, 32);
                if (fq == 0) atomicAdd(ssc + row, fixu(sq, SSC)); }
    }
};

struct EpiCmpPart {
    static constexpr int MID_TILE = 0;
    float* P;
    __device__ __forceinline__ void mid(f32x4 (&)[2][2][4][2], const Unit&, int, int) const {}
    __device__ __forceinline__ void operator()(AccRef acc, const Unit& u, int wr, int wc, int fr, int fq) const {
        int row0 = u.pm * BM + wr * 64 + fr; asm volatile("" : "+v"(row0)); const int col0 = wc * 32 + 8 * fq; float* base = P + (size_t)u.aux * (12 * NCP) * 256;
#pragma unroll
        for (int ai = 0; ai < 2; ++ai)
#pragma unroll
            for (int m = 0; m < 4; ++m) { float* rowp = base + (size_t)(row0 + ai * HALF + m * 16) * 256 + col0;
#pragma unroll
                for (int bj = 0; bj < 2; ++bj) { *(f32x4*)(rowp + bj * HALF) = acc[ai][bj][m][0]; *(f32x4*)(rowp + bj * HALF + 4) = acc[ai][bj][m][1]; } }
    }
};
struct CmpOrder {
    int G, c; long akv;
    __device__ bool next(int i, Unit& u) const {
        const int L = i * G + c; if (L >= 192) return false;
        const int kv = L / 96, r = L % 96, ks = r / 24, pm = r % 24;
        u.pm = pm; u.pn = 0; u.aux = kv * 4 + ks;
        u.ao = kv * akv + ((long)pm * 256 * 2048 + ks * 1024) * 2; u.bo = ((long)kv * 256 * 4096 + ks * 1024) * 2; return true;
    }
    __device__ __forceinline__ void a_ready(const Unit&) const {}
    __device__ __forceinline__ void done(const Unit&) const {}
};

struct EpiWin {
    static constexpr int MID_TILE = 0;
    const unsigned* ss;
    bf16_t *QRAW, *QROT, *KC, *VC, *KS, *VS, *KW, *VW, *U; float* G;
    __device__ __forceinline__ void mid(f32x4 (&)[2][2][4][2], const Unit&, int, int) const {}
    __device__ __forceinline__ void operator()(AccRef acc, const Unit& u, int wr, int wc, int fr, int fq) const {
        int row0 = u.pm * BM + wr * 64 + fr; asm volatile("" : "+v"(row0)); const int pn = u.pn;
        float invr[8];
#pragma unroll
        for (int j = 0; j < 8; ++j) invr[j] = exp2f(-(float)(32 * (wc & 1) + 8 * fq + j) * (13.287712379549449f / 64.f)) * 0.15915494309189535f;
        unsigned sv[8];
#pragma unroll
        for (int q = 0; q < 8; ++q) sv[q] = ss[row0 + (q >> 2) * HALF + (q & 3) * 16];
        asm volatile("" ::: "memory");
#pragma unroll
        for (int ai = 0; ai < 2; ++ai)
#pragma unroll
            for (int m = 0; m < 4; ++m) { const int row = row0 + ai * HALF + m * 16; const float r = rs_from(sv[ai * 4 + m], SSX_INV, 1.f / DM) * (SW8_INV / SA1);
                const int bb = row >> 13, s = row & (SEQ - 1);
                float a0[8], a1[8];
#pragma unroll
                for (int n = 0; n < 2; ++n)
#pragma unroll
                    for (int e = 0; e < 4; ++e) { a0[4 * n + e] = acc[ai][0][m][n][e] * r; a1[4 * n + e] = acc[ai][1][m][n][e] * r; }
                if (pn < 6) {
                    const int idx0 = 32 * (wc & 1) + 8 * fq; const int head = 2 * pn + (wc >> 1); const size_t qi = ((size_t)row * NH + head) * HD + idx0;
                    u32x4 r1, r2; r1.x = cvtpk(a0[0], a0[1]); r1.y = cvtpk(a0[2], a0[3]); r1.z = cvtpk(a0[4], a0[5]); r1.w = cvtpk(a0[6], a0[7]);
                    r2.x = cvtpk(a1[0], a1[1]); r2.y = cvtpk(a1[2], a1[3]); r2.z = cvtpk(a1[4], a1[5]); r2.w = cvtpk(a1[6], a1[7]);
                    *(u32x4*)(QRAW + qi) = r1; *(u32x4*)(QRAW + qi + 64) = r2;
                } else if (pn < 9) {
                    const int idx0 = 32 * (wc & 1) + 8 * fq;
                    float o1[8], o2[8]; const float sf = (float)s;
#pragma unroll
                    for (int j = 0; j < 8; ++j) {
                        const float fr = __builtin_amdgcn_fractf(sf * invr[j]); const float cc = __builtin_amdgcn_cosf(fr), sn = __builtin_amdgcn_sinf(fr);
                        o1[j] = a0[j] * cc - a1[j] * sn; o2[j] = a1[j] * cc + a0[j] * sn; }
                    { const int rh = 2 * (pn - 6) + (wc >> 1); unsigned char* dst = (unsigned char*)(rh < 3 ? KS : KW); const int kvh = rh < 3 ? rh : rh - 3;
                        const size_t ki = (((size_t)bb * NKV + kvh) * SEQ + s) * HD + idx0;
                        *(u32x2*)(dst + ki) = pk8_fp8(o1); *(u32x2*)(dst + ki + 64) = pk8_fp8(o2); }
                } else if (pn < 15) {
                    u32x4 w0, w1; w0.x = cvtpk(a0[0], a0[1]); w0.y = cvtpk(a0[2], a0[3]); w0.z = cvtpk(a0[4], a0[5]); w0.w = cvtpk(a0[6], a0[7]);
                    w1.x = cvtpk(a1[0], a1[1]); w1.y = cvtpk(a1[2], a1[3]); w1.z = cvtpk(a1[4], a1[5]); w1.w = cvtpk(a1[6], a1[7]);
                    const int col = 32 * wc + 8 * fq;
#pragma unroll
                    for (int bj = 0; bj < 2; ++bj) { const int ph = 2 * (pn - 9) + bj, tn = ph / 3, kvh = ph % 3;
                        bf16_t* dst = tn == 0 ? KC : (tn == 1 ? VC : (tn == 2 ? VS : VW));
                        *(u32x4*)(dst + (((size_t)bb * NKV + kvh) * SEQ + s) * HD + col) = bj ? w1 : w0; }
                } else if (pn < 19) {
                    float o[8];
#pragma unroll
                    for (int j = 0; j < 8; ++j) o[j] = a0[j] * sigmoidf_(a1[j]);
                    u32x4 w; w.x = cvtpk(o[0], o[1]); w.y = cvtpk(o[2], o[3]); w.z = cvtpk(o[4], o[5]); w.w = cvtpk(o[6], o[7]);
                    *(u32x4*)(U + (size_t)row * CCH + 128 * (pn - 15) + 32 * wc + 8 * fq) = w;
                } else {
                    const int col = 32 * wc + 8 * fq;
                    if (col < GLD) { f32x4 g0, g1;
#pragma unroll
                        for (int j = 0; j < 4; ++j) { g0[j] = sigmoidf_(a0[j]); g1[j] = sigmoidf_(a0[4 + j]); }
                        *(f32x4*)(G + (size_t)row * GLD + col) = g0; *(f32x4*)(G + (size_t)row * GLD + col + 4) = g1; }
                }
            }
    }
};
}

namespace att {
constexpr int SHM_K = 16384, SHM_V = 16384;
constexpr int L_V = 0, L_K = 32768, L_WS = 65536, L_IMP = 67584, L_OACC = 67584, L_SEL = 133120;
constexpr float SCALE = 0.08838834764831845f;
constexpr float THR = 5.5f;
#define KSWZ(row, colB) ((row) * 256 + ((colB) ^ (((row) & 7) << 4)))
__device__ __forceinline__ int v_st(int k, int c) { const int kk = (k & ~0xC) | ((k & 4) << 1) | ((k & 8) >> 1); return ((kk >> 3) * 4 + (c >> 5)) * 512 + ((kk & 7) * 32 + (c & 31)) * 2; }
__device__ __forceinline__ int v_rd_base(int lane) { return ((lane & 3) << 3) | (((lane >> 2) & 3) << 6) | (((lane >> 4) & 1) << 5) | (((lane >> 5) & 1) << 8); }
constexpr int v_rd_off(int d0, int ks, int half) { return d0 * 512 + ks * 4096 + half * 2048; }
__device__ __forceinline__ int crow(int r, int hi) { return (r & 3) + 8 * (r >> 2) + 4 * hi; }

__device__ __forceinline__ void mask_tile(f32x16& p0, f32x16& p1, int dq, unsigned W) {
    const float NEG = -__builtin_inff();
#pragma unroll
    for (int r = 0; r < 16; ++r) {
        const int c = (r & 3) + 8 * (r >> 2);
        if ((unsigned)(dq - c) >= W) p0[r] = NEG;
        if ((unsigned)(dq - c - 32) >= W) p1[r] = NEG;
    }
}
__device__ __forceinline__ void partialSM(f32x16& p0, f32x16& p1, float& m_reg, float& mn, float& alpha, bool sel = true) {
    float pmax = p0[0];
#pragma unroll
    for (int r = 1; r < 16; ++r) pmax = fmaxf(pmax, p0[r]);
#pragma unroll
    for (int r = 0; r < 16; ++r) pmax = fmaxf(pmax, p1[r]);
    { auto rr = __builtin_amdgcn_permlane32_swap(__float_as_uint(pmax), __float_as_uint(pmax), false, false);
      pmax = fmaxf(__uint_as_float(rr[0]), __uint_as_float(rr[1])); }
    constexpr float C2 = 1.4426950408889634f * SCALE;
    pmax = sel ? pmax : -__builtin_inff();
    if (__builtin_expect(__all((pmax - m_reg) * SCALE <= THR), 1)) { mn = m_reg; alpha = 1.f; }
    else { mn = fmaxf(m_reg, pmax); alpha = __builtin_amdgcn_exp2f((m_reg - mn) * C2); m_reg = mn; }
    const float mnL = sel ? -mn * C2 : -__builtin_inff();
#pragma unroll
    for (int r = 0; r < 16; ++r) p0[r] = fmaf(p0[r], C2, mnL);
#pragma unroll
    for (int r = 0; r < 16; ++r) p1[r] = fmaf(p1[r], C2, mnL);
#pragma unroll
    for (int r = 0; r < 16; ++r) p0[r] = __builtin_amdgcn_exp2f(p0[r]);
}
#define PK4(P, B_, OUT) do { unsigned a0 = cvtpk(P[B_+0], P[B_+1]), a1 = cvtpk(P[B_+2], P[B_+3]);                          \
        unsigned b0 = cvtpk(P[B_+4], P[B_+5]), b1 = cvtpk(P[B_+6], P[B_+7]);                                             \
        auto r0 = __builtin_amdgcn_permlane32_swap(a0, b0, false, false); auto r1 = __builtin_amdgcn_permlane32_swap(a1, b1, false, false); \
        u32x4 w = {r0[0], r1[0], r0[1], r1[1]}; OUT = *reinterpret_cast<bf16x8*>(&w); } while (0)
__device__ __forceinline__ void finishSM(f32x16& p0, f32x16& p1, float alpha, float& l_reg, bf16x8& pa0, bf16x8& pa1, bf16x8& pa2, bf16x8& pa3) {
#pragma unroll
    for (int r = 0; r < 16; ++r) p1[r] = __builtin_amdgcn_exp2f(p1[r]);
    float ps = 0;
#pragma unroll
    for (int r = 0; r < 16; ++r) ps += p0[r];
#pragma unroll
    for (int r = 0; r < 16; ++r) ps += p1[r];
    { auto rr = __builtin_amdgcn_permlane32_swap(__float_as_uint(ps), __float_as_uint(ps), false, false);
      ps = __uint_as_float(rr[0]) + __uint_as_float(rr[1]); }
    l_reg = l_reg * alpha + ps;
    PK4(p0, 0, pa0); PK4(p0, 8, pa1); PK4(p1, 0, pa2); PK4(p1, 8, pa3);
}
__device__ __forceinline__ void finishStats(f32x16& p0, f32x16& p1, float alpha, float& l_reg) {
#pragma unroll
    for (int r = 0; r < 16; ++r) p1[r] = __builtin_amdgcn_exp2f(p1[r]);
    float ps = 0;
#pragma unroll
    for (int r = 0; r < 16; ++r) ps += p0[r];
#pragma unroll
    for (int r = 0; r < 16; ++r) ps += p1[r];
    { auto rr = __builtin_amdgcn_permlane32_swap(__float_as_uint(ps), __float_as_uint(ps), false, false);
      ps = __uint_as_float(rr[0]) + __uint_as_float(rr[1]); }
    l_reg = l_reg * alpha + ps;
}
template <int KB>
__device__ __forceinline__ void qkt(f32x16& p0, f32x16& p1, LAS const char* K_lds, int r32, int hi, const bf16x8* qr) {
    p0 = f32x16{}; p1 = f32x16{};
    asm volatile("" : "+v"(r32));
    unsigned kb[4];
#pragma unroll
    for (int dd = 0; dd < 4; ++dd) kb[dd] = (unsigned)(uintptr_t)(K_lds + KB * SHM_K + KSWZ(r32, (dd * 16 + hi * 8) * 2));
#define KRD(dst, a, off) asm volatile("ds_read_b128 %0, %1 offset:%2" : "=v"(dst) : "v"(a), "i"(off) : "memory")
    bf16x8 f0, g0, f1, g1;
    KRD(f0, kb[0], 0); KRD(g0, kb[0], 8192); KRD(f1, kb[1], 0); KRD(g1, kb[1], 8192);
#define QK_STEP(d0, F, G, WAITN) do { asm volatile("s_waitcnt lgkmcnt(" #WAITN ")" ::: "memory"); SBAR(); \
        p0 = __builtin_amdgcn_mfma_f32_32x32x16_bf16(F, qr[d0], p0, 0, 0, 0); p1 = __builtin_amdgcn_mfma_f32_32x32x16_bf16(G, qr[d0], p1, 0, 0, 0); SBAR(); \
        if ((d0) + 2 < 8) { KRD(F, kb[((d0) + 2) & 3], (((d0) + 2) >> 2) * 128); KRD(G, kb[((d0) + 2) & 3], (((d0) + 2) >> 2) * 128 + 8192); } SBAR(); } while (0)
    QK_STEP(0, f0, g0, 2); QK_STEP(1, f1, g1, 2); QK_STEP(2, f0, g0, 2); QK_STEP(3, f1, g1, 2); QK_STEP(4, f0, g0, 2); QK_STEP(5, f1, g1, 2); QK_STEP(6, f0, g0, 2); QK_STEP(7, f1, g1, 0);
#undef QK_STEP
#undef KRD
}
template <int VB>
__device__ __forceinline__ void pv_tile(f32x16* o, int vb0, bf16x8 pa0, bf16x8 pa1, bf16x8 pa2, bf16x8 pa3) {
#define TRRD(dst, off) asm volatile("ds_read_b64_tr_b16 %0, %1 offset:%2" : "=&v"(dst) : "v"(vb0), "i"(off) : "memory")
#define PV_RD(i, L, H) do { constexpr int b_ = VB * SHM_V + v_rd_off((i) >> 2, (i) & 3, 0); TRRD(L, b_); TRRD(H, b_ + 2048); } while (0)
#define PV_MM(i, PA, L, H, WAITN) do { asm volatile("s_waitcnt lgkmcnt(" #WAITN ")" ::: "memory"); SBAR(); \
        o[(i) >> 2] = __builtin_amdgcn_mfma_f32_32x32x16_bf16(PA, (bf16x8){L[0], L[1], L[2], L[3], H[0], H[1], H[2], H[3]}, o[(i) >> 2], 0, 0, 0); SBAR(); \
        if ((i) + 4 < 16) PV_RD((i) + 4, L, H); SBAR(); } while (0)
    s16x4 l0, l1, l2, l3, h0, h1, h2, h3;
    PV_RD(0, l0, h0); PV_RD(1, l1, h1); PV_RD(2, l2, h2); PV_RD(3, l3, h3);
    PV_MM(0, pa0, l0, h0, 6); PV_MM(1, pa1, l1, h1, 6); PV_MM(2, pa2, l2, h2, 6); PV_MM(3, pa3, l3, h3, 6);
    PV_MM(4, pa0, l0, h0, 6); PV_MM(5, pa1, l1, h1, 6); PV_MM(6, pa2, l2, h2, 6); PV_MM(7, pa3, l3, h3, 6);
    PV_MM(8, pa0, l0, h0, 6); PV_MM(9, pa1, l1, h1, 6); PV_MM(10, pa2, l2, h2, 6); PV_MM(11, pa3, l3, h3, 6);
    PV_MM(12, pa0, l0, h0, 6); PV_MM(13, pa1, l1, h1, 4); PV_MM(14, pa2, l2, h2, 2); PV_MM(15, pa3, l3, h3, 0);
#undef PV_MM
#undef PV_RD
#undef TRRD
}

struct AttnP { const bf16_t *QRAW, *KCMP, *VCMP; const unsigned char *KS8, *KW8, *VTS, *VTW; const float* G; void* MIXED; unsigned* ssn; };

#define MFMA16(ACC, A, B) asm volatile("v_mfma_scale_f32_16x16x128_f8f6f4 %0, %1, %2, %0, %3, %3 op_sel_hi:[0,0,0]" : "+v"(ACC) : "v"(A), "v"(B), "v"(0x7f7f7f7fu))
#define MFMA16C(D, A, B, C, SA) asm volatile("v_mfma_scale_f32_16x16x128_f8f6f4 %0, %1, %2, %3, %4, %5 op_sel_hi:[0,0,0]" : "=&v"(D) : "v"(A), "v"(B), "v"(C), "v"(SA), "v"(0x7f7f7f7fu))
#define MFMA_DONE() asm volatile("s_nop 11" ::: "memory")
#define MFMA_PRE() asm volatile("s_nop 1" ::: "memory")
#define RD128(dst, a, off) asm volatile("ds_read_b128 %0, %1 offset:%2" : "=v"(dst) : "v"(a), "i"(off) : "memory")
#define LGK(n) asm volatile("s_waitcnt lgkmcnt(" #n ")" ::: "memory")
typedef int i32x8_t __attribute__((ext_vector_type(8)));
typedef int i32x4_t __attribute__((ext_vector_type(4)));
__device__ __forceinline__ i32x8_t cat88(i32x4_t a, i32x4_t b) { return __builtin_shufflevector(a, b, 0, 1, 2, 3, 4, 5, 6, 7); }
template <int CASE>
__device__ __forceinline__ void qk_half(f32x4 (&s0)[4], f32x4 (&s1)[4], const unsigned ka0, const unsigned ka1, const i32x8_t (&Qf)[2], const f32x4 (&cv)[2]) {
    const unsigned sk = 0x7c7c7c7cu;
    i32x4_t a0l, a0h, a1l, a1h;
    RD128(a0l, ka0, 0); RD128(a0h, ka1, 0); RD128(a1l, ka0, 2048); RD128(a1h, ka1, 2048);
#define QK_(m, lo, hi_) do { const i32x8_t K_ = cat88(lo, hi_); if constexpr (CASE & 1) MFMA16C(s0[m], K_, Qf[0], cv[0], sk); if constexpr (CASE & 2) MFMA16C(s1[m], K_, Qf[1], cv[1], sk); } while (0)
    LGK(2); SBAR(); MFMA_PRE(); QK_(0, a0l, a0h); SBAR(); RD128(a0l, ka0, 4096); RD128(a0h, ka1, 4096); LGK(2); SBAR(); QK_(1, a1l, a1h); SBAR(); RD128(a1l, ka0, 6144); RD128(a1h, ka1, 6144);
    LGK(2); SBAR(); QK_(2, a0l, a0h); SBAR(); LGK(0); SBAR(); QK_(3, a1l, a1h); SBAR(); MFMA_DONE();
#undef QK_
}
template <int CASE>
__device__ __forceinline__ void pv_step(f32x4 (&o0)[8], f32x4 (&o1)[8], const unsigned va0, const unsigned va1, const i32x8_t (&P8)[2]) {
    i32x4_t a0l, a0h, a1l, a1h;
#define PV_(db, lo, hi_) do { const i32x8_t V_ = cat88(lo, hi_); if constexpr (CASE & 1) MFMA16(o0[db], V_, P8[0]); if constexpr (CASE & 2) MFMA16(o1[db], V_, P8[1]); } while (0)
    RD128(a0l, va0, 0); RD128(a0h, va1, 0); RD128(a1l, va0, 2048); RD128(a1h, va1, 2048);
    MFMA_PRE();
#pragma unroll
    for (int q = 0; q < 3; ++q) {
        LGK(2); SBAR(); PV_(2 * q, a0l, a0h); SBAR(); RD128(a0l, va0, (2 * q + 2) * 2048); RD128(a0h, va1, (2 * q + 2) * 2048);
        LGK(2); SBAR(); PV_(2 * q + 1, a1l, a1h); SBAR(); RD128(a1l, va0, (2 * q + 3) * 2048); RD128(a1h, va1, (2 * q + 3) * 2048); }
    LGK(2); SBAR(); PV_(6, a0l, a0h); SBAR(); LGK(0); SBAR(); PV_(7, a1l, a1h); SBAR(); MFMA_DONE();
#undef PV_
}
__device__ __forceinline__ void mask16(f32x4 (&s)[4], const int dq, const unsigned W) {
#pragma unroll
    for (int m = 0; m < 4; ++m)
#pragma unroll
        for (int e = 0; e < 4; ++e) if ((unsigned)(dq - 16 * m - e) >= W) s[m][e] = -__builtin_inff();
}
__device__ __forceinline__ float max16(const f32x4 (&s)[4]) {
    float a = fmaxf(fmaxf(s[0][0], s[0][1]), s[0][2]), b = fmaxf(fmaxf(s[0][3], s[1][0]), s[1][1]);
    a = fmaxf(fmaxf(a, s[1][2]), s[1][3]); b = fmaxf(fmaxf(b, s[2][0]), s[2][1]); a = fmaxf(fmaxf(a, s[2][2]), s[2][3]); b = fmaxf(fmaxf(b, s[3][0]), s[3][1]);
    return fmaxf(fmaxf(fmaxf(a, s[3][2]), s[3][3]), b);
}
__device__ __forceinline__ i32x4_t exp_pack16(f32x4 (&s)[4], const bool sel, float& l) {
    float t0, t1, t2, t3;
    asm volatile("v_exp_f32 %4, %4\n\tv_exp_f32 %5, %5\n\tv_exp_f32 %6, %6\n\tv_exp_f32 %7, %7\n\tv_exp_f32 %8, %8\n\tv_exp_f32 %9, %9\n\tv_exp_f32 %10, %10\n\tv_exp_f32 %11, %11\n\t"
                 "v_exp_f32 %12, %12\n\tv_exp_f32 %13, %13\n\tv_exp_f32 %14, %14\n\tv_exp_f32 %15, %15\n\tv_exp_f32 %16, %16\n\tv_exp_f32 %17, %17\n\tv_exp_f32 %18, %18\n\tv_exp_f32 %19, %19\n\t"
                 "v_add_f32 %0, %4, %5\n\tv_add_f32 %1, %6, %7\n\tv_add_f32 %2, %8, %9\n\tv_add_f32 %3, %10, %11\n\t"
                 "v_add_f32 %0, %0, %12\n\tv_add_f32 %1, %1, %13\n\tv_add_f32 %2, %2, %14\n\tv_add_f32 %3, %3, %15\n\t"
                 "v_add_f32 %0, %0, %16\n\tv_add_f32 %1, %1, %17\n\tv_add_f32 %2, %2, %18\n\tv_add_f32 %3, %3, %19\n\t"
                 "v_add_f32 %0, %0, %1\n\tv_add_f32 %2, %2, %3\n\tv_add_f32 %0, %0, %2"
                 : "=&v"(t0), "=&v"(t1), "=&v"(t2), "=&v"(t3),
                   "+v"(s[0][0]), "+v"(s[0][1]), "+v"(s[0][2]), "+v"(s[0][3]), "+v"(s[1][0]), "+v"(s[1][1]), "+v"(s[1][2]), "+v"(s[1][3]),
                   "+v"(s[2][0]), "+v"(s[2][1]), "+v"(s[2][2]), "+v"(s[2][3]), "+v"(s[3][0]), "+v"(s[3][1]), "+v"(s[3][2]), "+v"(s[3][3]));
    const float ps = t0;
    l += sel ? ps : 0.f;
    unsigned u0, u1, u2, u3; asm volatile("" : "=v"(u0), "=v"(u1), "=v"(u2), "=v"(u3));
    u0 = __builtin_amdgcn_cvt_pk_fp8_f32(s[0][0], s[0][1], u0, false); u0 = __builtin_amdgcn_cvt_pk_fp8_f32(s[0][2], s[0][3], u0, true);
    u1 = __builtin_amdgcn_cvt_pk_fp8_f32(s[1][0], s[1][1], u1, false); u1 = __builtin_amdgcn_cvt_pk_fp8_f32(s[1][2], s[1][3], u1, true);
    u2 = __builtin_amdgcn_cvt_pk_fp8_f32(s[2][0], s[2][1], u2, false); u2 = __builtin_amdgcn_cvt_pk_fp8_f32(s[2][2], s[2][3], u2, true);
    u3 = __builtin_amdgcn_cvt_pk_fp8_f32(s[3][0], s[3][1], u3, false); u3 = __builtin_amdgcn_cvt_pk_fp8_f32(s[3][2], s[3][3], u3, true);
    return (i32x4_t){sel ? (int)u0 : 0, sel ? (int)u1 : 0, sel ? (int)u2 : 0, sel ? (int)u3 : 0};
}
__device__ __forceinline__ i32x4_t sm_quarter(f32x4 (&s)[4], const bool sel, const bool mk, const int dq, const unsigned W, float& mC, f32x4& cv, float& l, f32x4 (&o)[8], i32x4_t& pprev) {
    constexpr float THR2 = THR * 1.4426950408889634f;
    if (mk) mask16(s, dq, W);
    float pm = max16(s); pm = sel ? pm : -__builtin_inff();
    if (__builtin_expect(!__all(pm <= THR2), 0)) {
        float rm = pm; rm = fmaxf(rm, __shfl_xor(rm, 16)); rm = fmaxf(rm, __shfl_xor(rm, 32));
        const float d = fmaxf(rm, 0.f), alpha = __builtin_amdgcn_exp2f(-d); mC += d; l *= alpha;
#pragma unroll
        for (int m = 0; m < 4; ++m) s[m] -= d;
        cv = (f32x4){-mC, -mC, -mC, -mC};
#pragma unroll
        for (int db = 0; db < 8; ++db) o[db] *= alpha;
#pragma unroll
        for (int m = 0; m < 4; ++m) { const int w = pprev[m];
            unsigned u = __builtin_amdgcn_cvt_pk_fp8_f32(__builtin_amdgcn_cvt_f32_fp8(w, 0) * alpha, __builtin_amdgcn_cvt_f32_fp8(w, 1) * alpha, 0u, false);
            u = __builtin_amdgcn_cvt_pk_fp8_f32(__builtin_amdgcn_cvt_f32_fp8(w, 2) * alpha, __builtin_amdgcn_cvt_f32_fp8(w, 3) * alpha, u, true); pprev[m] = (int)u; }
    }
    return exp_pack16(s, sel, l);
}

__device__ __forceinline__ void attn_unit(const AttnP& P, int b, int g, int i, LAS char* lds, int wid) {
    const int lane = lane_id_(), tid = wid * 64 + lane, r32 = lane & 31, hi = lane >> 5;
    LAS char* V_lds = lds + L_V; LAS char* K_lds = lds + L_K;
    LAS float* ws = (LAS float*)(lds + L_WS) + wid * 64; LAS float* li_l = ws; LAS float* al_l = ws + 32;
    LAS float* impA = (LAS float*)(lds + L_IMP); LAS float* impB = impA + 64 * 128;
    LAS unsigned* oacc = (LAS unsigned*)(lds + L_OACC) + wid * 2048 + lane;
    LAS unsigned* selw = (LAS unsigned*)(lds + L_SEL);
    const int q0 = i * 64, tokl = 8 * wid + (r32 >> 2), head = r32 & 3, tpos = q0 + tokl;
    const size_t tokrow = (size_t)b * SEQ + tpos;
    const int bg = b * NKV + g;
    const unsigned koff0 = (unsigned)((wid * 8 + (lane >> 4)) * 256 + (((lane & 15) ^ (lane >> 4)) << 4)), koff1 = (unsigned)((wid * 8 + 4 + (lane >> 4)) * 256 + (((lane & 15) ^ (4 + (lane >> 4))) << 4));
    unsigned voff0; { const int kk = wid * 8 + ((lane >> 2) & 7), k = (kk & ~0xC) | ((kk & 4) << 1) | ((kk & 8) >> 1); voff0 = (unsigned)(k * 256 + ((lane >> 5) * 32 + (lane & 3) * 8) * 2); }
    const int vb0 = (int)(uintptr_t)V_lds + v_rd_base(lane);
    bf16x8 qr[8];
    f32x16 p0, p1; f32x16 o[4]; float m_reg, l_reg, mn, alpha; bf16x8 pa0, pa1, pa2, pa3;
    constexpr float C2 = 1.4426950408889634f * SCALE;

#define DMA_K(Kp, k0, buf) do { const char* b_ = (const char*)(Kp) + (size_t)(k0) * (HD * 2); LAS unsigned* d_ = (LAS unsigned*)(K_lds + (buf) * SHM_K + wid * 2048); \
        unsigned o0_ = koff0, o1_ = koff1; asm volatile("" : "+v"(o0_), "+v"(o1_)); \
        __builtin_amdgcn_global_load_lds((const unsigned*)(b_ + o0_), d_, 16, 0, 0); __builtin_amdgcn_global_load_lds((const unsigned*)(b_ + o1_), d_ + 256, 16, 0, 0); } while (0)
#define DMA_V(Vp, k0, buf) do { const char* b_ = (const char*)(Vp) + (size_t)(k0) * (HD * 2); LAS unsigned* d_ = (LAS unsigned*)(V_lds + (buf) * SHM_V + wid * 2048); \
        unsigned o0_ = voff0; asm volatile("" : "+v"(o0_)); \
        __builtin_amdgcn_global_load_lds((const unsigned*)(b_ + o0_), d_, 16, 0, 0); __builtin_amdgcn_global_load_lds((const unsigned*)(b_ + o0_ + 128), d_ + 256, 16, 0, 0); } while (0)
#define ABAR() asm volatile("s_waitcnt lgkmcnt(0)\n\ts_barrier" ::: "memory")
#define VMW(n) asm volatile("s_waitcnt vmcnt(" #n ")" ::: "memory")
#define RESC(a) do { if (__any((a) < 1.f)) { if (hi == 0) al_l[r32] = (a); LDS_WAIT();              \
                     _Pragma("unroll") for (int d_ = 0; d_ < 4; ++d_) _Pragma("unroll") for (int r = 0; r < 16; ++r) o[d_][r] *= al_l[crow(r, hi)]; } } while (0)
#define LOADQ(Qp) do { _Pragma("unroll") for (int d0 = 0; d0 < 8; ++d0) qr[d0] = *(const bf16x8*)((Qp) + (tokrow * NH + g * 4 + head) * HD + d0 * 16 + hi * 8); } while (0)

    const bf16_t* Kc = P.KCMP + (size_t)bg * NCP * HD; const bf16_t* Vc = P.VCMP + (size_t)bg * NCP * HD;
    const int ncmp = 4 * i + 3, NTC = (ncmp + 63) >> 6;
    const int tc = tpos >= 31 ? ((tpos - 31) >> 4) : -1;
    LOADQ(P.QRAW);
    m_reg = -1e30f; l_reg = 0.f;
    DMA_K(Kc, 0, 0); VMW(0); ABAR();
    for (int t = 0; t < NTC; ++t) {
        if (t + 1 < NTC) DMA_K(Kc, (t + 1) * 64, (t + 1) & 1);
        qkt<0>(p0, p1, K_lds + (t & 1) * SHM_K, r32, hi, qr);
        if (__any(t * 64 + 63 > tc)) mask_tile(p0, p1, tc - t * 64 - 4 * hi, 0x7fffffffu);
        partialSM(p0, p1, m_reg, mn, alpha); finishStats(p0, p1, alpha, l_reg);
        VMW(0); ABAR();
    }
    const float mL = l_reg > 0.f ? -m_reg * C2 - __builtin_amdgcn_logf(l_reg) : -__builtin_inff();
#pragma unroll
    for (int d = 0; d < 4; ++d) o[d] = f32x16{};
    DMA_K(Kc, 0, 0); DMA_V(Vc, 0, 0); VMW(0); ABAR();
    for (int t = 0; t < NTC; ++t) {
        if (t + 1 < NTC) { DMA_K(Kc, (t + 1) * 64, (t + 1) & 1); DMA_V(Vc, (t + 1) * 64, (t + 1) & 1); }
        qkt<0>(p0, p1, K_lds + (t & 1) * SHM_K, r32, hi, qr);
        if (__any(t * 64 + 63 > tc)) mask_tile(p0, p1, tc - t * 64 - 4 * hi, 0x7fffffffu);
#pragma unroll
        for (int r = 0; r < 16; ++r) { p0[r] = __builtin_amdgcn_exp2f(fmaf(p0[r], C2, mL)); p1[r] = __builtin_amdgcn_exp2f(fmaf(p1[r], C2, mL)); }
        if (i >= 16) {
#pragma unroll
            for (int q = 0; q < 8; ++q) {
                const float x0 = q < 4 ? p0[4 * q] : p1[4 * (q - 4)], x1 = q < 4 ? p0[4 * q + 1] : p1[4 * (q - 4) + 1], x2 = q < 4 ? p0[4 * q + 2] : p1[4 * (q - 4) + 2], x3 = q < 4 ? p0[4 * q + 3] : p1[4 * (q - 4) + 3];
                float av = 2.f * ((x0 + x1) + x2) + x3, bv = x3;
                av += dppf<DPP_X1>(av); av += dppf<DPP_X2>(av); bv += dppf<DPP_X1>(bv); bv += dppf<DPP_X2>(bv);
                const int jb = 16 * t + 2 * (q & 3) + hi + 8 * (q >> 2);
                if (head == 0) { impA[tokl * 128 + jb] = av; impB[tokl * 128 + jb] = bv; } }
        }
        PK4(p0, 0, pa0); PK4(p0, 8, pa1); PK4(p1, 0, pa2); PK4(p1, 8, pa3);
        pv_tile<0>(o, vb0 + (t & 1) * SHM_V, pa0, pa1, pa2, pa3);
        VMW(0); ABAR();
    }
    {
        int tk = tid; asm volatile("" : "+v"(tk));
        const int tl = tk >> 3, sub = tk & 7; unsigned sel = 0u;
        if (i < 16) {
#pragma unroll
            for (int jj = 0; jj < 16; ++jj) if (sub * 16 + jj <= i) sel |= 1u << jj;
        } else {
            unsigned key[16];
            LAS const float* ia = impA + tl * 128 + sub * 16; LAS const float* ib = impB + tl * 128 + sub * 16 - 1;
            float va[16];
#pragma unroll
            for (int jj = 0; jj < 16; ++jj) va[jj] = ia[jj] + ib[jj];
#pragma unroll
            for (int jj = 0; jj < 16; ++jj) { const int j = sub * 16 + jj; const bool valid = (j >= 1) && (j <= i - 2);
                key[jj] = valid ? ((__float_as_uint(va[jj]) & 0xFFFFFF80u) | (unsigned)(127 - j)) : 0u; }
#define TK_CE(a_, b_) do { const unsigned hi_ = key[a_] > key[b_] ? key[a_] : key[b_], lo_ = key[a_] > key[b_] ? key[b_] : key[a_]; key[a_] = hi_; key[b_] = lo_; } while (0)
#pragma unroll
            for (int p = 1; p < 16; p *= 2)
#pragma unroll
                for (int k = p; k >= 1; k /= 2)
#pragma unroll
                    for (int j = k % p; j + k < 16; j += 2 * k)
#pragma unroll
                        for (int i2 = 0; i2 < k; ++i2) if (i2 + j + k < 16 && (i2 + j) / (2 * p) == (i2 + j + k) / (2 * p)) TK_CE(i2 + j, i2 + j + k);
#undef TK_CE
#pragma unroll 1
            for (int round = 0; round < 13; ++round) {
                unsigned gm = key[0]; { unsigned o1 = dppu<DPP_X1>(gm); gm = gm > o1 ? gm : o1; o1 = dppu<DPP_X2>(gm); gm = gm > o1 ? gm : o1; o1 = dppu<DPP_HM>(gm); gm = gm > o1 ? gm : o1; }
                const bool win = key[0] == gm && gm != 0u;
                sel |= win ? 1u << ((127u - (gm & 127u)) & 15u) : 0u;
#pragma unroll
                for (int q = 0; q < 15; ++q) key[q] = win ? key[q + 1] : key[q];
                key[15] = win ? 0u : key[15];
            }
#pragma unroll
            for (int jj = 0; jj < 16; ++jj) { const int j = sub * 16 + jj; if (j == 0 || j == i || j == i - 1) sel |= 1u << jj; }
        }
        __syncthreads();
        ((LAS unsigned short*)selw)[tl * 8 + sub] = (unsigned short)sel;
    }
    {
        if (hi == 0) li_l[r32] = P.G[tokrow * GLD + (g * 4 + head) * 3 + 0];
        LDS_WAIT(); SBAR();
        LAS char* img = lds + L_OACC + wid * 8192;
#pragma unroll
        for (int r = 0; r < 16; ++r) { const int row = crow(r, hi); const float gt = li_l[row]; LAS char* ir = img + row * 256;
#pragma unroll
            for (int d0 = 0; d0 < 4; ++d0) { const int d = d0 * 32 + r32;
                *(LAS unsigned short*)(ir + ((((d >> 2) ^ ((row & 15) << 1))) << 3) + ((d & 3) << 1)) = (unsigned short)cvtpk(o[d0][r] * gt, 0.f); } }
    }
    LDS_WAIT(); __syncthreads();

    {
    int l2 = lane_id_(); asm volatile("" : "+v"(l2));
    const int n = l2 & 15, kg = l2 >> 4;
    i32x8_t Qf[2]; int tposh[2]; constexpr float QSC = 8.f * 1.4426950408889634f * SCALE;
#pragma unroll
    for (int h = 0; h < 2; ++h) {
        tposh[h] = q0 + 8 * wid + 4 * h + (n >> 2);
        const float tp = (float)tposh[h], sgn = kg < 2 ? -1.f : 1.f;
        const bf16_t* qrow = P.QRAW + (((size_t)b * SEQ + tposh[h]) * NH + g * 4 + (n & 3)) * HD;
        const int dA = 32 * kg, dB = dA ^ 64;
#pragma unroll
        for (int c = 0; c < 4; ++c) { const u32x4 xa = *(const u32x4*)(qrow + dA + 8 * c), xb = *(const u32x4*)(qrow + dB + 8 * c); float rr[8];
#pragma unroll
            for (int jj = 0; jj < 8; ++jj) { const float a = (jj & 1) ? bfhi(xa[jj >> 1]) : bflo(xa[jj >> 1]), pb = (jj & 1) ? bfhi(xb[jj >> 1]) : bflo(xb[jj >> 1]);
                const float invr = exp2f(-(float)(32 * (kg & 1) + 8 * c + jj) * (13.287712379549449f / 64.f)) * 0.15915494309189535f;
                const float fr_ = __builtin_amdgcn_fractf(tp * invr); const float cc = __builtin_amdgcn_cosf(fr_), sn = __builtin_amdgcn_sinf(fr_);
                rr[jj] = (a * cc + sgn * (pb * sn)) * QSC; }
            const u32x2 w = pk8_fp8(rr); Qf[h][2 * c] = (int)w.x; Qf[h][2 * c + 1] = (int)w.y; } }
    unsigned kof0, kof1, vof0, vof1, kra0, kra1, vra0, vra1;
    { const int r0 = 16 * wid + (l2 >> 3), r1 = r0 + 8, sl = l2 & 7;
      kof0 = (unsigned)(r0 * 128 + ((sl ^ ((r0 >> 1) & 7)) << 4)); kof1 = (unsigned)(r1 * 128 + ((sl ^ ((r1 >> 1) & 7)) << 4));
      vof0 = (unsigned)(r0 * SEQ + ((sl ^ ((r0 >> 1) & 7)) << 4)); vof1 = (unsigned)(r1 * SEQ + ((sl ^ ((r1 >> 1) & 7)) << 4));
      const int sw = (n >> 1) & 7;
      kra0 = (unsigned)(uintptr_t)K_lds + (unsigned)(n * 128 + (((2 * kg) ^ sw) << 4)); kra1 = (unsigned)(uintptr_t)K_lds + (unsigned)(n * 128 + (((2 * kg + 1) ^ sw) << 4));
      vra0 = (unsigned)(uintptr_t)V_lds + (unsigned)(n * 128 + ((kg ^ sw) << 4)); vra1 = (unsigned)(uintptr_t)V_lds + (unsigned)(n * 128 + (((4 + kg) ^ sw) << 4)); }
#pragma unroll 1
    for (int br = 1; br <= 2; ++br) {
        const unsigned char* Kp = (br == 1 ? P.KS8 : P.KW8) + (size_t)bg * SEQ * HD; const unsigned char* Vp = (br == 1 ? P.VTS : P.VTW) + (size_t)bg * HD * SEQ;
        const int jlo = br == 1 ? 0 : (i > 8 ? i - 8 : 0), NS = (i - jlo + 2) >> 1;
        const unsigned W = br == 1 ? 0x7fffffffu : 512u;
        unsigned sw00 = 0, sw01 = 0, sw02 = 0, sw03 = 0, sw10 = 0, sw11 = 0, sw12 = 0, sw13 = 0;
        if (br == 1) { const int t0 = (8 * wid + (n >> 2)) * 4, t1 = t0 + 16;
            sw00 = selw[t0]; sw01 = selw[t0 + 1]; sw02 = selw[t0 + 2]; sw03 = selw[t0 + 3]; sw10 = selw[t1]; sw11 = selw[t1 + 1]; sw12 = selw[t1 + 2]; sw13 = selw[t1 + 3]; }
#define SELW0(j_) ((((j_) & 64) ? (((j_) & 32) ? sw03 : sw02) : (((j_) & 32) ? sw01 : sw00)) >> ((j_) & 31))
#define SELW1(j_) ((((j_) & 64) ? (((j_) & 32) ? sw13 : sw12) : (((j_) & 32) ? sw11 : sw10)) >> ((j_) & 31))
        f32x4 o0[8], o1[8];
#pragma unroll
        for (int db = 0; db < 8; ++db) { o0[db] = (f32x4){0.f, 0.f, 0.f, 0.f}; o1[db] = (f32x4){0.f, 0.f, 0.f, 0.f}; }
        float mC0 = 0.f, mC1 = 0.f, l0 = 0.f, l1 = 0.f;
        f32x4 cv[2] = {(f32x4){0.f, 0.f, 0.f, 0.f}, (f32x4){0.f, 0.f, 0.f, 0.f}};
        i32x4_t pl0 = {0, 0, 0, 0}, ph0 = {0, 0, 0, 0}, pl1 = {0, 0, 0, 0}, ph1 = {0, 0, 0, 0};
        f32x4 sa0[4], sa1[4];
        bool pa0 = false, pa1 = false;
#define DMA_K16(J_) do { const unsigned char* b_ = Kp + (size_t)(jlo + 2 * (J_)) * 64 * HD; LAS unsigned* d_ = (LAS unsigned*)(K_lds + ((J_) & 1) * 16384 + wid * 2048); \
            unsigned o0_ = kof0, o1_ = kof1; asm volatile("" : "+v"(o0_), "+v"(o1_)); \
            __builtin_amdgcn_global_load_lds((const unsigned*)(b_ + o0_), d_, 16, 0, 0); __builtin_amdgcn_global_load_lds((const unsigned*)(b_ + o1_), d_ + 256, 16, 0, 0); } while (0)
#define DMA_V16(J_) do { const unsigned char* b_ = Vp + (size_t)(jlo + 2 * (J_)) * 64; LAS unsigned* d_ = (LAS unsigned*)(V_lds + ((J_) & 1) * 16384 + wid * 2048); \
            unsigned o0_ = vof0, o1_ = vof1; asm volatile("" : "+v"(o0_), "+v"(o1_)); \
            __builtin_amdgcn_global_load_lds((const unsigned*)(b_ + o0_), d_, 16, 0, 0); __builtin_amdgcn_global_load_lds((const unsigned*)(b_ + o1_), d_ + 256, 16, 0, 0); } while (0)
        DMA_K16(0); VMW(0); ABAR();
        if (wid < 4) __builtin_amdgcn_s_setprio(1);
#pragma unroll 1
        for (int J = 0; J <= NS; ++J) {
            if (J < NS) DMA_V16(J);
            if (J + 1 < NS) DMA_K16(J + 1);
            if (J >= 1 && (pa0 || pa1)) { const unsigned vs_ = (unsigned)(((J - 1) & 1) * 16384); const i32x8_t P8[2] = {cat88(pl0, ph0), cat88(pl1, ph1)};
                pv_step<3>(o0, o1, vra0 + vs_, vra1 + vs_, P8);
                }
            pa0 = false; pa1 = false;
            if (J < NS) {
#pragma unroll
                for (int c = 0; c < 2; ++c) {
                    const int jc = jlo + 2 * J + c;
                    bool s0, s1;
                    if (br == 1) { s0 = SELW0(jc) & 1u; s1 = SELW1(jc) & 1u; } else { s0 = jc <= i; s1 = s0; }
                    const bool a0 = __any(s0), a1 = __any(s1);
                    const unsigned ks_ = (unsigned)((J & 1) * 16384 + c * 8192);
                        if (a0 && a1) qk_half<3>(sa0, sa1, kra0 + ks_, kra1 + ks_, Qf, cv); else if (a0) qk_half<1>(sa0, sa1, kra0 + ks_, kra1 + ks_, Qf, cv); else if (a1) qk_half<2>(sa0, sa1, kra0 + ks_, kra1 + ks_, Qf, cv);
                    const bool mk = (jc == i) || (br == 2 && jc + 8 == i);
                    i32x4_t q0_ = {0, 0, 0, 0}, q1_ = {0, 0, 0, 0};
                    if (a0) q0_ = sm_quarter(sa0, s0, mk, tposh[0] - jc * 64 - 4 * kg, W, mC0, cv[0], l0, o0, pl0);
                    if (a1) q1_ = sm_quarter(sa1, s1, mk, tposh[1] - jc * 64 - 4 * kg, W, mC1, cv[1], l1, o1, pl1);
                    if (c == 0) { pl0 = q0_; pl1 = q1_; } else { ph0 = q0_; ph1 = q1_; }
                    pa0 = pa0 || a0; pa1 = pa1 || a1;
                }
            }
            VMW(0); ABAR();
        }
        __builtin_amdgcn_s_setprio(0);
#undef DMA_K16
#undef DMA_V16
#undef SELW0
#undef SELW1
        const int l3 = lane_id_(), n = l3 & 15, kg = l3 >> 4; const int tposh[2] = {q0 + 8 * wid + (n >> 2), q0 + 8 * wid + 4 + (n >> 2)};
        LAS char* img = lds + L_OACC + wid * 8192;
        l0 += __shfl_xor(l0, 16); l0 += __shfl_xor(l0, 32); l1 += __shfl_xor(l1, 16); l1 += __shfl_xor(l1, 32);
        float gs[2];
        { const float g0_ = P.G[((size_t)b * SEQ + tposh[0]) * GLD + (g * 4 + (n & 3)) * 3 + br], g1_ = P.G[((size_t)b * SEQ + tposh[1]) * GLD + (g * 4 + (n & 3)) * 3 + br];
          gs[0] = l0 > 0.f ? g0_ / l0 : 0.f; gs[1] = l1 > 0.f ? g1_ / l1 : 0.f; }
        if (br == 1) {
#pragma unroll
            for (int h = 0; h < 2; ++h)
#pragma unroll
                for (int db = 0; db < 8; ++db) { LAS u32x2* ip = (LAS u32x2*)(img + (16 * h + n) * 256 + (((4 * db + kg) ^ (2 * n)) << 3)); const u32x2 w = *ip; const f32x4 ov = (h ? o1[db] : o0[db]) * gs[h];
                    *ip = (u32x2){cvtpk(bflo(w.x) + ov[0], bfhi(w.x) + ov[1]), cvtpk(bflo(w.y) + ov[2], bfhi(w.y) + ov[3])}; }
            LDS_WAIT();
        } else {
#pragma unroll
            for (int h = 0; h < 2; ++h) { float sq = 0.f;
                unsigned char* orow = (unsigned char*)P.MIXED + ((size_t)b * SEQ + tposh[h]) * DM + CCH + (g * 4 + (n & 3)) * HD + 4 * kg;
#pragma unroll
                for (int db = 0; db < 8; ++db) { const u32x2 w = *(LAS const u32x2*)(img + (16 * h + n) * 256 + (((4 * db + kg) ^ (2 * n)) << 3)); const f32x4 ov = (h ? o1[db] : o0[db]) * gs[h];
                    const float v0 = bflo(w.x) + ov[0], v1 = bfhi(w.x) + ov[1], v2 = bflo(w.y) + ov[2], v3 = bfhi(w.y) + ov[3];
                    sq += (v0 * v0 + v1 * v1) + (v2 * v2 + v3 * v3);
                    if constexpr (OUT_FP8) { unsigned w8 = __builtin_amdgcn_cvt_pk_fp8_f32(clamp448(v0 * A8N), clamp448(v1 * A8N), 0u, false); w8 = __builtin_amdgcn_cvt_pk_fp8_f32(clamp448(v2 * A8N), clamp448(v3 * A8N), w8, true);
                        *(unsigned*)(orow + 16 * db) = w8; }
                    else { *(u32x2*)((bf16_t*)P.MIXED + ((size_t)b * SEQ + tposh[h]) * DM + CCH + (g * 4 + (n & 3)) * HD + 16 * db + 4 * kg) = (u32x2){cvtpk(v0, v1), cvtpk(v2, v3)}; } }
                sq += dppf<DPP_X1>(sq); sq += dppf<DPP_X2>(sq); sq += __shfl_xor(sq, 16); sq += __shfl_xor(sq, 32);
                if ((n & 3) == 0 && kg == 0) atomicAdd(P.ssn + (size_t)b * SEQ + tposh[h], fixu(sq, SSN)); }
        }
    }
    }
    __syncthreads();
#undef DMA_K
#undef DMA_V
#undef ABAR
#undef VMW
#undef RESC
#undef LOADQ
}
#undef PK4
#undef KSWZ
}

#define XB_TMO      128
#define XB_XCNT(j)  (256  + 64 * (j))
#define XB_XSUB(j)  (1280 + 64 * (j))
#define XB_XGEN(j)  (2304 + 64 * (j))
#define XB_TOP      3328
#define XB_TOPGEN   3392
#define XCD_BAR_WORDS 3456
#define XB_SPIN_CAP (1u << 20)
__device__ __forceinline__ unsigned xb_ld(unsigned* p)              { return __hip_atomic_load(p, __ATOMIC_RELAXED, __HIP_MEMORY_SCOPE_AGENT); }
__device__ __forceinline__ unsigned xb_add(unsigned* p, unsigned v) { return __hip_atomic_fetch_add(p, v, __ATOMIC_RELAXED, __HIP_MEMORY_SCOPE_AGENT); }
__device__ __forceinline__ unsigned xb_xcc_id() { return (unsigned)__builtin_amdgcn_s_getreg((3 << 11) | 20) & 0xFu; }
#define XB_SPIN(cond, bar) do { unsigned _sp = 0; while (cond) { __builtin_amdgcn_s_sleep(1); \
    if ((++_sp & 255u) == 0u) { if (xb_ld(&(bar)[XB_TMO])) break; if (_sp > XB_SPIN_CAP) { atomicAdd(&(bar)[XB_TMO], 1u); break; } } } } while (0)
struct XcdBarrier { unsigned* bar; unsigned x; volatile LAS unsigned* st; int wave; };
__device__ __forceinline__ XcdBarrier xcd_barrier_post(unsigned* bar, volatile LAS unsigned* st, int wave) {
    XcdBarrier b; b.bar = bar; b.x = xb_xcc_id(); b.st = st; b.wave = wave;
    if (wave == 0 && lane_id_() == 0) (void)xb_add(&bar[XB_XCNT(b.x)], 1u);
    return b;
}
__device__ __forceinline__ void xcd_barrier_complete(unsigned* bar, unsigned x, unsigned& nloc, unsigned& nx) {
    const unsigned G = gridDim.x * gridDim.y * gridDim.z;
    unsigned sum, cnt, mine, sp = 0u;
    for (;;) {
        sum = 0u; cnt = 0u; mine = 0u;
#pragma unroll
        for (unsigned j = 0; j < 16; ++j) { const unsigned c = xb_ld(&bar[XB_XCNT(j)]); sum += c; cnt += (c > 0u) ? 1u : 0u; mine = (j == x) ? c : mine; }
        if (sum == G) break;
        __builtin_amdgcn_s_sleep(1);
        if ((++sp & 255u) == 0u) { if (xb_ld(&bar[XB_TMO])) break; if (sp > XB_SPIN_CAP) { atomicAdd(&bar[XB_TMO], 1u); break; } }
    }
    nloc = mine > 0u ? mine : 1u; nx = cnt > 0u ? cnt : 1u;
}
__device__ __forceinline__ void xcd_barrier(const XcdBarrier& b) {
    asm volatile("s_waitcnt vmcnt(0)" ::: "memory");
    __syncthreads();
    if (b.wave == 0 && lane_id_() == 0) {
        unsigned* bar = b.bar;
        __builtin_amdgcn_s_waitcnt(0);
        unsigned nloc = b.st[0], nx = b.st[1];
        if (nloc == 0u) { xcd_barrier_complete(bar, b.x, nloc, nx); b.st[0] = nloc; b.st[1] = nx; }
        const unsigned old = xb_add(&bar[XB_XSUB(b.x)], 1u);
        const unsigned gen = old / nloc;
        if (old + 1u == (gen + 1u) * nloc) {
            __builtin_amdgcn_fence(__ATOMIC_RELEASE, "agent");
            asm volatile("s_waitcnt vmcnt(0)" ::: "memory");
            const unsigned og = xb_add(&bar[XB_TOP], 1u);
            const unsigned tg = og / nx;
            if (og + 1u == (tg + 1u) * nx) xb_add(&bar[XB_TOPGEN], 1u);
            else XB_SPIN(xb_ld(&bar[XB_TOPGEN]) == tg, bar);
            __builtin_amdgcn_fence(__ATOMIC_ACQUIRE, "agent");
            xb_add(&bar[XB_XGEN(b.x)], 1u);
            asm volatile("s_waitcnt vmcnt(0)" ::: "memory");
        } else {
            XB_SPIN(xb_ld(&bar[XB_XGEN(b.x)]) == gen, bar);
            __builtin_amdgcn_fence(__ATOMIC_ACQUIRE, "agent");
            asm volatile("s_waitcnt vmcnt(0)" ::: "memory");
        }
    }
    __syncthreads();
}

__device__ __forceinline__ int win_row(int n) {
    if (n < 512) return 256 * (15 + (n >> 7)) + (n & 127);
    if (n < 1024) { const int j = n - 512; return 256 * (15 + (j >> 7)) + 128 + (j & 127); }
    if (n < 2560) { const int j = n - 1024, h = j >> 7, e = j & 127; return 256 * (h >> 1) + 128 * (e >> 6) + 64 * (h & 1) + (e & 63); }
    if (n < 4864) { const int j = n - 2560, blk = j / 384, r = j % 384, h = r >> 7, e = r & 127;
        if (blk == 2 || blk == 4) { const int rh = (blk == 2 ? 0 : 3) + h; return 256 * (6 + (rh >> 1)) + 128 * (e >> 6) + 64 * (rh & 1) + (e & 63); }
        const int ph = (blk == 0 ? 0 : (blk == 1 ? 3 : (blk == 3 ? 6 : 9))) + h; return 256 * (9 + (ph >> 1)) + 128 * (ph & 1) + e; }
    return 256 * 19 + (n - 4864);
}
__device__ __forceinline__ int dest_row(int kind, int n) {
    if (kind == 0) return n;
    if (kind == 1) return ((n >> 7) << 8) + (n & 127);
    if (kind == 2) return ((n >> 7) << 8) + 128 + (n & 127);
    return win_row(n);
}
template <int QM = 0>
__device__ __forceinline__ void transpose_item(const float* W, int K, int N, void* WTv, int kind, const float* gk, float s, int item, int lane, int KP = 0) {
    constexpr bool F8 = QM != 0; constexpr int KI = F8 ? 128 : 64, KL = KI / 8;
    const int nblk = (N + 31) / 32, kb = item / nblk, nb = item % nblk, k0 = KI * kb + KL * (lane >> 3), n0 = 32 * nb + 4 * (lane & 7);
    if (n0 >= N) return;
    f32x4 v[KL];
    const float* src = W + (size_t)k0 * N + n0;
#pragma unroll
    for (int i = 0; i < KL; ++i) v[i] = *(const f32x4*)(src + (size_t)i * N);
    if (gk) {
#pragma unroll
        for (int i = 0; i < KL; i += 4) { const f32x4 g = *(const f32x4*)(gk + k0 + i); v[i] *= g.x; v[i + 1] *= g.y; v[i + 2] *= g.z; v[i + 3] *= g.w; } }
#pragma unroll
    for (int j = 0; j < 4; ++j) { const int dr = dest_row(kind, n0 + j);
        if constexpr (F8) { float a[8], b[8];
#pragma unroll
            for (int i = 0; i < 8; ++i) { a[i] = v[i][j] * s; b[i] = v[8 + i][j] * s; }
            const u32x2 lo = QM == 2 ? pk8_i8(a, 1.f) : pk8_fp8(a), hi = QM == 2 ? pk8_i8(b, 1.f) : pk8_fp8(b);
            *(u32x4*)((unsigned char*)WTv + (size_t)dr * KP + k0) = (u32x4){lo.x, lo.y, hi.x, hi.y}; }
        else { u32x4 o; o.x = cvtpk(v[0][j] * s, v[1][j] * s); o.y = cvtpk(v[2][j] * s, v[3][j] * s); o.z = cvtpk(v[4][j] * s, v[5][j] * s); o.w = cvtpk(v[6][j] * s, v[7][j] * s);
            *(u32x4*)((bf16_t*)WTv + (size_t)dr * K + k0) = o; } }
}

#define CAS __attribute__((address_space(4)))
typedef const float* const CAS* InTab;
struct Frame {
    LAS unsigned char* lds; int wave, vcu, G;
    InTab in; float* out; unsigned char* ws;
};
#define FRESH_IN(F) do { InTab t_ = (F).in; asm volatile("" : "+s"(t_)); (F).in = t_; } while (0)

__device__ __forceinline__ void p0_prologue(Frame& F) {
    const int LN = lane_id_();
    const int gw = F.vcu * NWAVES + F.wave, NGW = F.G * NWAVES;
    unsigned char* ws = F.ws;
    constexpr int I_F = (DM / 128) * (FF / 32), I_D = (FF / 128) * (DM / 32), I_IN = (DM / 128) * ((NIN + 31) / 32), I_O = (DM / (OUT_FP8 ? 128 : 64)) * (DM / 32), I_C = (4096 / 64) * (256 / 32), I_P = (CCH / 64) * (CCH / 32);
    constexpr int NITEMS = 4 * I_F + 2 * I_D + I_IN + I_O + 2 * I_C + I_P;
    for (int it = gw; it < NITEMS; it += NGW) {
        int r = it;
        if (r < I_F) { transpose_item<2>(F.in[2], DM, FF, ws + WS_WGU1, 1, F.in[1], SW8, r, LN, DM); continue; } r -= I_F;
        if (r < I_F) { transpose_item<2>(F.in[3], DM, FF, ws + WS_WGU1, 2, F.in[1], SW8, r, LN, DM); continue; } r -= I_F;
        if (r < I_F) { transpose_item<2>(F.in[22], DM, FF, ws + WS_WGU2, 1, F.in[21], SW8, r, LN, DM); continue; } r -= I_F;
        if (r < I_F) { transpose_item<2>(F.in[23], DM, FF, ws + WS_WGU2, 2, F.in[21], SW8, r, LN, DM); continue; } r -= I_F;
        if (r < I_D) { transpose_item<1>(F.in[4], FF, DM, ws + WS_WD1, 0, nullptr, 0.5f * W8S, r, LN, FFP); continue; } r -= I_D;
        if (r < I_D) { transpose_item<1>(F.in[24], FF, DM, ws + WS_WD2, 0, nullptr, 0.5f * W8S, r, LN, FFP); continue; } r -= I_D;
        if (r < I_IN) { transpose_item<2>(F.in[6], DM, NIN, ws + WS_WIN, 3, F.in[5], SW8, r, LN, DM); continue; } r -= I_IN;
        if (r < I_O) { const int kb = r / (DM / 32);
            if (OUT_FP8) transpose_item<1>(F.in[20], DM, DM, ws + WS_WOUT, 0, kb < 4 ? F.in[18] : F.in[19] - CCH, W8S, r, LN, DM);
            else transpose_item(F.in[20], DM, DM, ws + WS_WOUT, 0, kb < 8 ? F.in[18] : F.in[19] - CCH, 1.f, r, LN); continue; } r -= I_O;
        if (r < I_C) { transpose_item(F.in[9], 4096, 256, ws + WS_WC1, 0, nullptr, 1.f, r, LN); continue; } r -= I_C;
        if (r < I_C) { transpose_item(F.in[11], 4096, 256, (bf16_t*)(ws + WS_WC1) + 256 * 4096, 0, nullptr, 1.f, r, LN); continue; } r -= I_C;
        transpose_item(F.in[17], CCH, CCH, ws + WS_WPW, 0, nullptr, 1.f, r, LN);
    }
    for (int rr = gw; rr < 220; rr += NGW) { u32x4* p = (u32x4*)(ws + WS_WIN + (size_t)(256 * 19 + 36 + rr) * DM);
#pragma unroll
        for (int j = 0; j < 2; ++j) p[LN + 64 * j] = (u32x4){0u, 0u, 0u, 0u}; }
    for (int rr = gw; rr < 2 * 256; rr += NGW) { u32x4* p = (u32x4*)(ws + (rr < 256 ? WS_WGU1 : WS_WGU2) + (size_t)(43 * 256 + (rr & 255)) * DM);
#pragma unroll
        for (int j = 0; j < 2; ++j) p[LN + 64 * j] = (u32x4){0u, 0u, 0u, 0u}; }
    for (int rr = gw; rr < 2 * DM / 8; rr += NGW) { const int which = rr / (DM / 8), r8 = (rr % (DM / 8)) * 8 + (LN >> 3);
        *(u32x4*)(ws + (which ? WS_WD2 : WS_WD1) + (size_t)r8 * FFP + FF + (LN & 7) * 16) = (u32x4){0u, 0u, 0u, 0u}; }
    { const float* x = F.in[0]; unsigned char* XB8 = ws + WS_XB8; unsigned* ss0 = (unsigned*)(ws + WS_SS0); float* rowf = (float*)(ws + WS_ROWF);
      for (int m = gw; m < T; m += NGW) { const f32x4* xr = (const f32x4*)(x + (size_t)m * DM) + 2 * LN; u32x2* o8 = (u32x2*)(XB8 + (size_t)m * DM) + LN; float s = 0.f, am = 0.f;
          f32x4 v[4], w[4];
#pragma unroll
          for (int j = 0; j < 4; ++j) { v[j] = xr[128 * j]; w[j] = xr[128 * j + 1]; }
#pragma unroll
          for (int j = 0; j < 4; ++j) { s += (v[j].x * v[j].x + v[j].y * v[j].y) + (v[j].z * v[j].z + v[j].w * v[j].w) + (w[j].x * w[j].x + w[j].y * w[j].y) + (w[j].z * w[j].z + w[j].w * w[j].w);
              am = fmaxf(fmaxf(fmaxf(am, fmaxf(fabsf(v[j].x), fabsf(v[j].y))), fmaxf(fabsf(v[j].z), fabsf(v[j].w))), fmaxf(fmaxf(fabsf(w[j].x), fabsf(w[j].y)), fmaxf(fabsf(w[j].z), fabsf(w[j].w)))); }
#pragma unroll
          for (int o = 1; o < 64; o <<= 1) am = fmaxf(am, __shfl_xor(am, o));
          am = fmaxf(am, 1e-20f); const float qs = 127.f / am;
#pragma unroll
          for (int j = 0; j < 4; ++j) { const float v8[8] = {v[j].x, v[j].y, v[j].z, v[j].w, w[j].x, w[j].y, w[j].z, w[j].w}; o8[64 * j] = pk8_i8(v8, qs); }
          s = wave_sum(s); if (LN == 0) { ss0[m] = fixu(s, SSX); rowf[m] = am * (1.f / 127.f); } } }
    { float* b1p = (float*)(ws + WS_B1) + 1024;
      for (int o = gw; o < 32; o += NGW) { const int kv = o >> 4, ch = o & 15; const float* pos = F.in[kv ? 8 : 7] + ch * 256; const float* w1 = F.in[kv ? 11 : 9] + (size_t)ch * 256 * 256 + LN * 4;
          f32x4 a = {0.f, 0.f, 0.f, 0.f};
#pragma unroll 8
          for (int k = 0; k < 256; ++k) a += *(const f32x4*)(w1 + (size_t)k * 256) * pos[k];
          *(f32x4*)(b1p + o * 256 + LN * 4) = a; } }
}

__device__ __forceinline__ void conv_phase(Frame& F) {
    const int LN = lane_id_(); const int TID = F.wave * 64 + LN;
    const bf16_t* U = (const bf16_t*)(F.ws + WS_U); bf16_t* S1 = (bf16_t*)(F.ws + WS_S1);
    const float* dw = F.in[13]; const int c = TID;
    float w[31];
#pragma unroll
    for (int k = 0; k < 31; ++k) w[k] = dw[k * CCH + c];
    const float bias = F.in[14][c];
    LAS float* ybuf = (LAS float*)F.lds;
    f32x4 lg0, lg1, lb0, lb1;
    { const float* g = F.in[15] + LN * 8; const float* bb = F.in[16] + LN * 8; lg0 = *(const f32x4*)g; lg1 = *(const f32x4*)(g + 4); lb0 = *(const f32x4*)bb; lb1 = *(const f32x4*)(bb + 4); }
    unsigned short ub[62];
#define CONV_LOAD(tile_) do { const int t0_ = (tile_) * 32, s0_ = t0_ & (SEQ - 1); _Pragma("unroll") for (int j = 0; j < 62; ++j) { const int pos = s0_ - 30 + j; ub[j] = pos >= 0 ? U[(size_t)(t0_ - 30 + j) * CCH + c] : (unsigned short)0; } } while (0)
    if (F.vcu < T / 32) CONV_LOAD(F.vcu);
    for (int tile = F.vcu; tile < T / 32; tile += F.G) {
        const int t0 = tile * 32;
        float u[62];
#pragma unroll
        for (int j = 0; j < 62; ++j) u[j] = bf2f(ub[j]);
#pragma unroll
        for (int tt = 0; tt < 32; ++tt) { float y = bias;
#pragma unroll
            for (int k = 0; k < 31; ++k) y = fmaf(w[k], u[tt + k], y);
            ybuf[tt * CCH + c] = y; }
        if (tile + F.G < T / 32) CONV_LOAD(tile + F.G);
        asm volatile("s_waitcnt lgkmcnt(0)\n\ts_barrier" ::: "memory");
#pragma unroll
        for (int q = 0; q < 4; ++q) { const int tt = F.wave * 4 + q; const LAS float* yr = ybuf + tt * CCH + LN * 8;
            const f32x4 y0 = *(const LAS f32x4*)yr, y1 = *(const LAS f32x4*)(yr + 4);
            float s = (y0.x + y0.y) + (y0.z + y0.w) + (y1.x + y1.y) + (y1.z + y1.w);
            const float mu = wave_sum(s) * (1.f / CCH);
            const f32x4 d0 = y0 - mu, d1 = y1 - mu;
            float s2 = (d0.x * d0.x + d0.y * d0.y) + (d0.z * d0.z + d0.w * d0.w) + (d1.x * d1.x + d1.y * d1.y) + (d1.z * d1.z + d1.w * d1.w);
            const float rstd = 1.0f / sqrtf(wave_sum(s2) * (1.f / CCH) + EPS);
            const f32x4 z0 = d0 * rstd * lg0 + lb0, z1 = d1 * rstd * lg1 + lb1;
            u32x4 o; o.x = cvtpk(siluf_(z0.x), siluf_(z0.y)); o.y = cvtpk(siluf_(z0.z), siluf_(z0.w)); o.z = cvtpk(siluf_(z1.x), siluf_(z1.y)); o.w = cvtpk(siluf_(z1.z), siluf_(z1.w));
            *(u32x4*)(S1 + (size_t)(t0 + tt) * CCH + LN * 8) = o; }
        asm volatile("s_waitcnt lgkmcnt(0)\n\ts_barrier" ::: "memory");
    }
#undef CONV_LOAD
}

__device__ __forceinline__ void vt8_phase(Frame& F) {
    const int LN = lane_id_(); const int TID = F.wave * 64 + LN; const int d = TID & 127, kg = TID >> 7;
    for (int id = F.vcu; id < 2 * 12 * (SEQ / 64); id += F.G) { const int tn = id / (12 * (SEQ / 64)), r = id % (12 * (SEQ / 64)), bg = r / (SEQ / 64), j = r % (SEQ / 64);
        const bf16_t* src = (const bf16_t*)(F.ws + (tn ? WS_VW : WS_VS)) + ((size_t)bg * SEQ + 64 * j + 4 * kg) * HD + d;
        float a[8], b[8];
#pragma unroll
        for (int i = 0; i < 8; ++i) { a[i] = bf2f(src[(size_t)(16 * (i >> 2) + (i & 3)) * HD]); b[i] = bf2f(src[(size_t)(32 + 16 * (i >> 2) + (i & 3)) * HD]); }
        const u32x2 lo = pk8_fp8(a), hi = pk8_fp8(b);
        *(u32x4*)(F.ws + (tn ? WS_VTW : WS_VTS) + ((size_t)bg * HD + d) * SEQ + 64 * j + 16 * kg) = (u32x4){lo.x, lo.y, hi.x, hi.y}; }
}

__device__ __forceinline__ void cmp2_phase(Frame& F) {
    const int LN = lane_id_();
    const float* Pp = (const float*)(F.ws + WS_CMPP); const float* b1 = (const float*)(F.ws + WS_B1);
    constexpr int RW = 6;
    LAS float* hb = (LAS float*)F.lds + F.wave * (RW * 256);
    for (int grp = F.vcu; grp < (2 * 12 * NCP) / (8 * RW); grp += F.G) {
        const int row0 = (grp * 8 + F.wave) * RW, kv = row0 / (12 * NCP);
#pragma unroll
        for (int r = 0; r < RW; ++r) { const int m = (row0 + r) % (12 * NCP);
            f32x4 h = *(const f32x4*)(b1 + kv * 256 + LN * 4);
#pragma unroll
            for (int ks = 0; ks < 4; ++ks) h += *(const f32x4*)(Pp + ((size_t)(kv * 4 + ks) * (12 * NCP) + m) * 256 + LN * 4);
            h.x = siluf_(h.x); h.y = siluf_(h.y); h.z = siluf_(h.z); h.w = siluf_(h.w);
            *(LAS f32x4*)(hb + r * 256 + LN * 4) = h; }
        LDS_WAIT();
        const float* w2g = F.in[kv ? 12 : 10]; float a0[RW], a1[RW];
        LAS float* wl = (LAS float*)F.lds + 8 * RW * 256;
#pragma unroll
        for (int r = 0; r < RW; ++r) { a0[r] = 0.f; a1[r] = 0.f; }
#pragma unroll 1
        for (int half = 0; half < 2; ++half) {
            asm volatile("s_waitcnt lgkmcnt(0)\n\ts_barrier" ::: "memory");
#pragma unroll
            for (int pc = 0; pc < 8; ++pc) { const int piece = F.wave * 8 + pc;
                __builtin_amdgcn_global_load_lds((const unsigned*)(w2g + half * 16384 + piece * 256 + LN * 4), (LAS unsigned*)(wl + piece * 256), 16, 0, 0); }
            asm volatile("s_waitcnt vmcnt(0)\n\ts_barrier" ::: "memory");
#pragma unroll 2
            for (int k = 0; k < 128; k += 4) {
                const f32x2 w0 = *(const LAS f32x2*)(wl + (k + 0) * HD + LN * 2), w1 = *(const LAS f32x2*)(wl + (k + 1) * HD + LN * 2), w2v = *(const LAS f32x2*)(wl + (k + 2) * HD + LN * 2), w3 = *(const LAS f32x2*)(wl + (k + 3) * HD + LN * 2);
#pragma unroll
                for (int r = 0; r < RW; ++r) { const f32x4 hv = *(const LAS f32x4*)(hb + r * 256 + half * 128 + k);
                    a0[r] = fmaf(hv.x, w0.x, a0[r]); a1[r] = fmaf(hv.x, w0.y, a1[r]); a0[r] = fmaf(hv.y, w1.x, a0[r]); a1[r] = fmaf(hv.y, w1.y, a1[r]);
                    a0[r] = fmaf(hv.z, w2v.x, a0[r]); a1[r] = fmaf(hv.z, w2v.y, a1[r]); a0[r] = fmaf(hv.w, w3.x, a0[r]); a1[r] = fmaf(hv.w, w3.y, a1[r]); } }
        }
        bf16_t* dst = (bf16_t*)(F.ws + (kv ? WS_VCMP : WS_KCMP));
#pragma unroll
        for (int r = 0; r < RW; ++r) { const int m = (row0 + r) % (12 * NCP); const bool last = (m & (NCP - 1)) == NCP - 1;
            *(unsigned*)(dst + (size_t)m * HD + LN * 2) = last ? 0u : cvtpk(a0[r], a1[r]); }
        LDS_WAIT();
    }
}

__device__ __forceinline__ void final_phase(Frame& F) {
    const int LN = lane_id_();
    const unsigned* ss3 = (const unsigned*)(F.ws + WS_SS3); const float* gf = F.in[25]; const bf16_t* XB = (const bf16_t*)(F.ws + WS_XB);
    const int gw = F.vcu * NWAVES + F.wave, NGW = F.G * NWAVES;
    f32x4 g0[4], g1[4];
#pragma unroll
    for (int j = 0; j < 4; ++j) { g0[j] = *((const f32x4*)gf + 2 * (LN + 64 * j)); g1[j] = *((const f32x4*)gf + 2 * (LN + 64 * j) + 1); }
    for (int m = gw; m < T; m += NGW) { const u32x4* xr = (const u32x4*)(XB + (size_t)m * DM) + LN; f32x4* orow = (f32x4*)(F.out + (size_t)m * DM); const float r = rs_from(ss3[m], SSX_INV, 1.f / DM);
#pragma unroll
        for (int j = 0; j < 4; ++j) { const u32x4 w = xr[64 * j];
            orow[2 * (LN + 64 * j)] = (f32x4){bflo(w.x), bfhi(w.x), bflo(w.y), bfhi(w.y)} * r * g0[j]; orow[2 * (LN + 64 * j) + 1] = (f32x4){bflo(w.z), bfhi(w.z), bflo(w.w), bfhi(w.w)} * r * g1[j]; } }
}

constexpr int N_PHASES = 11;
struct Args { const float* in[26]; float* out; unsigned char* ws; int ph_lo, ph_hi; };
__global__ void __launch_bounds__(NWAVES * 64, 2) hymba_fwd(Args args) {
    extern __shared__ __attribute__((aligned(16))) unsigned char lds[];
    Frame F;
    F.lds = (LAS unsigned char*)lds;
    volatile LAS unsigned* MISC = (volatile LAS unsigned*)(F.lds + MISC_OFF);
    F.wave = __builtin_amdgcn_readfirstlane((int)threadIdx.x >> 6);
    F.G = gridDim.x; { const int bx = blockIdx.x; F.vcu = (F.G % 8 == 0) ? (bx % 8) * (F.G / 8) + bx / 8 : bx; }
    F.in = (InTab)__builtin_amdgcn_kernarg_segment_ptr();
    F.out = args.out; F.ws = args.ws;
    unsigned char* ws = args.ws;
    unsigned* ctl = (unsigned*)(ws + WS_CTL);
    for (int u = F.wave * 64 + lane_id_(); u < (LDS_BYTES - LDSCTL_OFF) / 4; u += NWAVES * 64) ((LAS unsigned*)(F.lds + LDSCTL_OFF))[u] = 0u;
    __syncthreads();
    const int lo = args.ph_lo, hi = args.ph_hi;
    const bool one = (hi - lo) > 1;
    XcdBarrier bar; bar.bar = ctl + CW_BAR; bar.x = 0; bar.st = nullptr; bar.wave = 0;
    if (one) bar = xcd_barrier_post(ctl + CW_BAR, MISC + 8, F.wave);
#ifndef PH_MASK
#define PH_MASK 0x7ff
#endif
#define IN(k) (((PH_MASK >> (k)) & 1) && lo <= (k) && (k) < hi)
#define GRID_BAR(k) do { if (IN(k) && IN((k) + 1)) xcd_barrier(bar); } while (0)
    bf16_t* XB = (bf16_t*)(ws + WS_XB); unsigned char* ACT = ws + WS_ACT; unsigned char* XB8 = ws + WS_XB8;
    unsigned* ss0 = (unsigned*)(ws + WS_SS0); unsigned* ss1 = (unsigned*)(ws + WS_SS1); unsigned* ss2 = (unsigned*)(ws + WS_SS2); unsigned* ss3 = (unsigned*)(ws + WS_SS3);
    unsigned* ssc = (unsigned*)(ws + WS_SSC); unsigned* ssn = (unsigned*)(ws + WS_SSN);

#ifndef PROBE_DUP
#define PROBE_DUP 0
#endif
#define DUP(k) ((PROBE_DUP >> (k)) & 1)
    if (IN(0)) { FRESH_IN(F); if (DUP(0)) { p0_prologue(F); if (one) xcd_barrier(bar); } p0_prologue(F); } GRID_BAR(0);
    if (IN(1)) { pg8::Gemm g{(const bf16_t*)XB8, (const bf16_t*)(ws + WS_WGU1), DM / 2, DM / 2, DM / 2}; pg8::StaticOrder S; S.init(T, 2 * FFP, F.G, (int)blockIdx.x, DM / 2, DM / 2);
        pg8::EpiSwiGLU E{ACT, ss0, (const float*)(ws + WS_ROWF), SW8_INV};
        pg8::gemm_phase<pg8::EpiSwiGLU, pg8::StaticOrder, true, 2>(F.lds, g, S, E, F.wave); } GRID_BAR(1);
    if (IN(2)) { FRESH_IN(F); pg8::Gemm g{(const bf16_t*)ACT, (const bf16_t*)(ws + WS_WD1), FFP / 2, FFP / 2, FFP / 2}; pg8::StaticOrder S; S.init(T, DM, F.G, (int)blockIdx.x, FFP / 2, FFP / 2);
        if (DUP(2)) { pg8::EpiResid<0> E2{F.in[0], XB, nullptr, ss0, nullptr, nullptr}; pg8::gemm_phase<pg8::EpiResid<0>, pg8::StaticOrder, true, 1>(F.lds, g, S, E2, F.wave); if (one) xcd_barrier(bar); }
        pg8::EpiResid<0> E{F.in[0], XB, XB8, ss1, nullptr, nullptr}; pg8::gemm_phase<pg8::EpiResid<0>, pg8::StaticOrder, true, 1>(F.lds, g, S, E, F.wave); } GRID_BAR(2);
    if (IN(3)) { constexpr int KD = DM / 2; pg8::Gemm g{(const bf16_t*)XB8, (const bf16_t*)(ws + WS_WIN), KD, KD, KD}; pg8::StaticOrder S; S.init(T, NWIN, F.G, (int)blockIdx.x, KD, KD);
        pg8::EpiWin E{ss1,
            (bf16_t*)(ws + WS_QRAW), (bf16_t*)(ws + WS_QROT), (bf16_t*)(ws + WS_KC), (bf16_t*)(ws + WS_VC), (bf16_t*)(ws + WS_KS), (bf16_t*)(ws + WS_VS), (bf16_t*)(ws + WS_KW), (bf16_t*)(ws + WS_VW),
            (bf16_t*)(ws + WS_U), (float*)(ws + WS_G)};
        pg8::gemm_phase<pg8::EpiWin, pg8::StaticOrder, true, 2>(F.lds, g, S, E, F.wave); } GRID_BAR(3);
    if (IN(4)) { FRESH_IN(F); if (F.vcu == 0) { const int TID = F.wave * 64 + lane_id_(); const float* b1p = (const float*)(ws + WS_B1) + 1024; float sacc = 0.f;
#pragma unroll
            for (int ch = 0; ch < 16; ++ch) sacc += b1p[((TID >> 8) * 16 + ch) * 256 + (TID & 255)];
            ((float*)(ws + WS_B1))[TID] = sacc; }
        conv_phase(F); vt8_phase(F);
        if (DUP(4)) { conv_phase(F); pg8::Gemm g{(const bf16_t*)(ws + WS_KC), (const bf16_t*)(ws + WS_WC1), 1024, 2048, 4096}; pg8::CmpOrder S{F.G, (int)blockIdx.x, (long)(WS_VC - WS_KC)};
            pg8::EpiCmpPart E{(float*)(ws + WS_CMPP)}; pg8::gemm_phase<pg8::EpiCmpPart, pg8::CmpOrder, false, 0>(F.lds, g, S, E, F.wave); if (one) xcd_barrier(bar); }
        pg8::Gemm g{(const bf16_t*)(ws + WS_KC), (const bf16_t*)(ws + WS_WC1), 1024, 2048, 4096}; pg8::CmpOrder S{F.G, (int)blockIdx.x, (long)(WS_VC - WS_KC)};
        pg8::EpiCmpPart E{(float*)(ws + WS_CMPP)}; pg8::gemm_phase<pg8::EpiCmpPart, pg8::CmpOrder, false, 0>(F.lds, g, S, E, F.wave); } GRID_BAR(4);
    if (IN(5)) { FRESH_IN(F); if (DUP(5)) { pg8::Gemm g{(const bf16_t*)(ws + WS_S1), (const bf16_t*)(ws + WS_WPW), CCH, CCH, CCH}; pg8::StaticOrder S; S.init(T, CCH, F.G, (int)blockIdx.x, CCH, CCH);
        pg8::EpiPw E{(void*)(ws + WS_MIXED), ss0}; pg8::gemm_phase<pg8::EpiPw, pg8::StaticOrder, false, 0>(F.lds, g, S, E, F.wave); cmp2_phase(F); if (one) xcd_barrier(bar); }
        { pg8::Gemm g{(const bf16_t*)(ws + WS_S1), (const bf16_t*)(ws + WS_WPW), CCH, CCH, CCH}; pg8::StaticOrder S; S.init(T, CCH, F.G, (int)blockIdx.x, CCH, CCH);
        pg8::EpiPw E{(void*)(ws + WS_MIXED), ssc}; pg8::gemm_phase<pg8::EpiPw, pg8::StaticOrder, false, 0>(F.lds, g, S, E, F.wave); }
        cmp2_phase(F); } GRID_BAR(5);
    if (IN(6)) { const att::AttnP P{(const bf16_t*)(ws + WS_QRAW), (const bf16_t*)(ws + WS_KCMP), (const bf16_t*)(ws + WS_VCMP), ws + WS_KS, ws + WS_KW, ws + WS_VTS, ws + WS_VTW,
            (const float*)(ws + WS_G), (void*)(ws + WS_MIXED), ssn};
        if (DUP(6)) { att::AttnP P2 = P; P2.ssn = ss0;
            for (int p = F.vcu; p < 12 * 64; p += F.G) { const int bg = p >> 6, x = p & 63, b = bg / NKV, g = bg % NKV;
                att::attn_unit(P2, b, g, x, (LAS char*)F.lds, F.wave); att::attn_unit(P2, b, g, 127 - x, (LAS char*)F.lds, F.wave); }
            if (one) xcd_barrier(bar); }
        for (int p = F.vcu, k = 0; p < 12 * 64; p += F.G, ++k) { const int bg = p >> 6, x = ((p & 63) + 21 * k) & 63, b = bg / NKV, g = bg % NKV;
            att::attn_unit(P, b, g, x, (LAS char*)F.lds, F.wave); att::attn_unit(P, b, g, 127 - x, (LAS char*)F.lds, F.wave); } } GRID_BAR(6);
    if (IN(7)) { constexpr int KO = OUT_FP8 ? DM / 2 : DM; pg8::Gemm g{(const bf16_t*)(ws + WS_MIXED), (const bf16_t*)(ws + WS_WOUT), KO, KO, KO}; pg8::StaticOrder S; S.init(T, DM, F.G, (int)blockIdx.x, KO, KO);
        pg8::EpiResid<1> E{nullptr, XB, XB8, ss2, ssc, ssn}; pg8::gemm_phase<pg8::EpiResid<1>, pg8::StaticOrder, true, OUT_FP8 ? 1 : 0>(F.lds, g, S, E, F.wave); } GRID_BAR(7);
    if (IN(8)) { pg8::Gemm g{(const bf16_t*)XB8, (const bf16_t*)(ws + WS_WGU2), DM / 2, DM / 2, DM / 2}; pg8::StaticOrder S; S.init(T, 2 * FFP, F.G, (int)blockIdx.x, DM / 2, DM / 2);
        pg8::EpiSwiGLU E{ACT, ss2, nullptr, SW8_INV / SA2}; pg8::gemm_phase<pg8::EpiSwiGLU, pg8::StaticOrder, true, 2>(F.lds, g, S, E, F.wave); } GRID_BAR(8);
    if (IN(9)) { pg8::Gemm g{(const bf16_t*)ACT, (const bf16_t*)(ws + WS_WD2), FFP / 2, FFP / 2, FFP / 2}; pg8::StaticOrder S; S.init(T, DM, F.G, (int)blockIdx.x, FFP / 2, FFP / 2);
        pg8::EpiResid<2> E{nullptr, XB, nullptr, ss3, nullptr, nullptr}; pg8::gemm_phase<pg8::EpiResid<2>, pg8::StaticOrder, true, 1>(F.lds, g, S, E, F.wave); } GRID_BAR(9);
    if (IN(10)) { FRESH_IN(F); final_phase(F); }
#undef IN
#undef GRID_BAR
}

extern "C" void kernel_launch(void* const* d_in, const int* in_sizes, int n_in, void* d_out, int out_size, void* d_ws, size_t ws_size, hipStream_t stream) {
    static int grid = 0;
    if (grid == 0) {
        if (n_in != 26 || in_sizes[0] != T * DM || out_size != T * DM || ws_size < WS_END) { fprintf(stderr, "kernel_launch: unexpected shapes (n_in %d, ws %zu)\n", n_in, ws_size); grid = -1; return; }
        int dev = 0, cus = 0, per_cu = 0;
        if (hipGetDevice(&dev) != hipSuccess || hipDeviceGetAttribute(&cus, hipDeviceAttributeMultiprocessorCount, dev) != hipSuccess) { grid = -1; return; }
        if (hipFuncSetAttribute((const void*)hymba_fwd, hipFuncAttributeMaxDynamicSharedMemorySize, LDS_BYTES) != hipSuccess) { grid = -1; return; }
        if (hipOccupancyMaxActiveBlocksPerMultiprocessor(&per_cu, (const void*)hymba_fwd, NWAVES * 64, LDS_BYTES) != hipSuccess || per_cu < 1) { fprintf(stderr, "kernel_launch: occupancy query says %d\n", per_cu); }
        (void)hipGetLastError();
        grid = cus;
    }
    if (grid < 0) return;
    if (hipMemsetAsync((char*)d_ws + WS_CTL, 0, CTL_ZERO_BYTES, stream) != hipSuccess) return;
    Args a{};
    for (int i = 0; i < 26; ++i) a.in[i] = (const float*)d_in[i];
    a.out = (float*)d_out; a.ws = (unsigned char*)d_ws;
#if MK_N_LAUNCHES == 1
    a.ph_lo = 0; a.ph_hi = N_PHASES;
    hipLaunchKernelGGL(hymba_fwd, dim3(grid), dim3(NWAVES * 64), LDS_BYTES, stream, a);
#else
    for (int p = 0; p < N_PHASES; ++p) { a.ph_lo = p; a.ph_hi = p + 1; hipLaunchKernelGGL(hymba_fwd, dim3(grid), dim3(NWAVES * 64), LDS_BYTES, stream, a); }
#endif
}
```

```cpp
#include <hip/hip_runtime.h>
#include <hip/hip_bf16.h>
#include <cstdio>
#include <cstdint>

#ifndef OUT_FP8
#define OUT_FP8 1
#endif
#ifndef MK_N_LAUNCHES
#define MK_N_LAUNCHES 1
#endif

#define GAS __attribute__((address_space(1)))
#define LAS __attribute__((address_space(3)))
typedef unsigned short bf16_t;
typedef short bf16x8 __attribute__((ext_vector_type(8)));
typedef short s16x4 __attribute__((ext_vector_type(4)));
typedef float f32x4 __attribute__((ext_vector_type(4)));
typedef float f32x2 __attribute__((ext_vector_type(2)));
typedef float f32x16 __attribute__((ext_vector_type(16)));
typedef unsigned u32x4 __attribute__((ext_vector_type(4)));
typedef unsigned u32x2 __attribute__((ext_vector_type(2)));

constexpr int BATCH = 4, SEQ = 8192, DM = 2048, T = BATCH * SEQ, FF = 5504, NH = 12, HD = 128, NKV = 3, CCH = 512, NIN = 4900;
constexpr int FFP = 5632;
constexpr float W8S = 64.f, W8S_INV = 1.f / 64.f;
constexpr float SW8 = 127.f * 45.254833995939045f / 5.5f, SW8_INV = 1.f / SW8, SA1 = 127.f / 5.75f, SA2 = 127.f / 8.f;
constexpr float A8C = 8.f, A8N = 16.f;
constexpr int NCP = 512;
constexpr int NWIN = 20 * 256;
constexpr float EPS = 1e-6f;
constexpr float SSX = 4096.f, SSX_INV = 1.f / 4096.f;
constexpr float SSC = 65536.f, SSC_INV = 1.f / 65536.f;
constexpr float SSN = 262144.f, SSN_INV = 1.f / 262144.f;

constexpr size_t MiB = 1u << 20;
constexpr size_t WS_CTL = 0, CTL_ZERO_BYTES = 2 * MiB;
constexpr size_t WS_SS1 = 1 * MiB, WS_SS2 = WS_SS1 + 131072, WS_SS3 = WS_SS2 + 131072, WS_SSC = WS_SS3 + 131072, WS_SSN = WS_SSC + 131072;
constexpr size_t WS_SS0 = 2 * MiB, WS_B1 = 2 * MiB + 262144, WS_ROWF = 2 * MiB + 524288;
constexpr size_t WS_WGU1 = 8 * MiB, WS_WD1 = 30 * MiB, WS_WGU2 = 41 * MiB, WS_WD2 = 63 * MiB;
constexpr size_t WS_XB8 = 74 * MiB;
constexpr size_t WS_WIN = 138 * MiB, WS_WOUT = 158 * MiB, WS_WC1 = 166 * MiB, WS_WPW = 170 * MiB;
constexpr size_t WS_XB = 172 * MiB;
constexpr size_t WS_ACT = 300 * MiB;
constexpr size_t WS_QRAW = 300 * MiB, WS_QROT = 396 * MiB, WS_KC = 492 * MiB, WS_VC = 517 * MiB, WS_KS = 542 * MiB, WS_VS = 566 * MiB, WS_KW = 590 * MiB, WS_VW = 614 * MiB;
constexpr size_t WS_U = 638 * MiB, WS_S1 = 670 * MiB, WS_G = 702 * MiB, WS_MIXED = 708 * MiB, WS_CMPP = 836 * MiB, WS_KCMP = 884 * MiB, WS_VCMP = 886 * MiB;
constexpr size_t WS_VTS = 396 * MiB, WS_VTW = 408 * MiB;
constexpr size_t WS_END = 888 * MiB;
constexpr int GLD = 40;

constexpr int CW_BAR = 4096;

constexpr int RING_BYTES = 131072;
constexpr int LDSCTL_OFF = 143360 - 1024, MISC_OFF = LDSCTL_OFF + 320;
constexpr int LDS_BYTES = 147456;
constexpr int NWAVES = 8;

#define LDS_WAIT() asm volatile("s_waitcnt lgkmcnt(0)" ::: "memory")
#define VM_WAIT() asm volatile("s_waitcnt vmcnt(0)" ::: "memory")
#define SBAR() __builtin_amdgcn_sched_barrier(0)

__device__ __forceinline__ int lane_id_() { int l; asm volatile("v_mbcnt_lo_u32_b32 %0, -1, 0\n\tv_mbcnt_hi_u32_b32 %0, -1, %0" : "=v"(l)); return l; }
__device__ __forceinline__ unsigned cvtpk(float lo, float hi) { unsigned r; asm volatile("v_cvt_pk_bf16_f32 %0, %1, %2" : "=v"(r) : "v"(lo), "v"(hi)); return r; }
__device__ __forceinline__ float clamp448(float v) { return __builtin_amdgcn_fmed3f(v, -448.f, 448.f); }
__device__ __forceinline__ u32x2 pk8_fp8(const float* v) {
    unsigned w0 = 0u, w1 = 0u;
    w0 = __builtin_amdgcn_cvt_pk_fp8_f32(clamp448(v[0]), clamp448(v[1]), w0, false); w0 = __builtin_amdgcn_cvt_pk_fp8_f32(clamp448(v[2]), clamp448(v[3]), w0, true);
    w1 = __builtin_amdgcn_cvt_pk_fp8_f32(clamp448(v[4]), clamp448(v[5]), w1, false); w1 = __builtin_amdgcn_cvt_pk_fp8_f32(clamp448(v[6]), clamp448(v[7]), w1, true);
    return (u32x2){w0, w1};
}
__device__ __forceinline__ u32x2 pk8_i8(const float* v, float scale) {
    unsigned t[8];
#pragma unroll
    for (int j = 0; j < 8; ++j) t[j] = __float_as_uint(__builtin_amdgcn_fmed3f(v[j] * scale, -127.f, 127.f) + 12582912.f);
    const unsigned lo = __builtin_amdgcn_perm(__builtin_amdgcn_perm(t[3], t[2], 0x0c0c0400u) << 16, __builtin_amdgcn_perm(t[1], t[0], 0x0c0c0400u), 0x07060100u);
    const unsigned hi = __builtin_amdgcn_perm(__builtin_amdgcn_perm(t[7], t[6], 0x0c0c0400u) << 16, __builtin_amdgcn_perm(t[5], t[4], 0x0c0c0400u), 0x07060100u);
    return (u32x2){lo, hi};
}
__device__ __forceinline__ float bf2f(unsigned short h) { return __uint_as_float((unsigned)h << 16); }
__device__ __forceinline__ float bflo(unsigned w) { return __uint_as_float(w << 16); }
__device__ __forceinline__ float bfhi(unsigned w) { return __uint_as_float(w & 0xffff0000u); }
__device__ __forceinline__ float wave_sum(float v) {
    v += __builtin_bit_cast(float, __builtin_amdgcn_update_dpp(0, __builtin_bit_cast(int, v), 0xB1, 0xF, 0xF, true));
    v += __builtin_bit_cast(float, __builtin_amdgcn_update_dpp(0, __builtin_bit_cast(int, v), 0x4E, 0xF, 0xF, true));
    v += __builtin_bit_cast(float, __builtin_amdgcn_update_dpp(0, __builtin_bit_cast(int, v), 0x141, 0xF, 0xF, true));
    v += __builtin_bit_cast(float, __builtin_amdgcn_update_dpp(0, __builtin_bit_cast(int, v), 0x140, 0xF, 0xF, true));
    { auto rr = __builtin_amdgcn_permlane16_swap(__float_as_uint(v), __float_as_uint(v), false, false); v = __uint_as_float(rr[0]) + __uint_as_float(rr[1]); }
    { auto rr = __builtin_amdgcn_permlane32_swap(__float_as_uint(v), __float_as_uint(v), false, false); v = __uint_as_float(rr[0]) + __uint_as_float(rr[1]); }
    return v;
}
template <int CTRL> __device__ __forceinline__ float dppf(float v) { return __builtin_bit_cast(float, __builtin_amdgcn_update_dpp(0, __builtin_bit_cast(int, v), CTRL, 0xF, 0xF, true)); }
template <int CTRL> __device__ __forceinline__ unsigned dppu(unsigned v) { return (unsigned)__builtin_amdgcn_update_dpp(0, (int)v, CTRL, 0xF, 0xF, true); }
#define DPP_X1 0xB1
#define DPP_X2 0x4E
#define DPP_HM 0x141
#define DPP_RM 0x140
__device__ __forceinline__ float sigmoidf_(float v) { return __builtin_amdgcn_rcpf(1.f + __builtin_amdgcn_exp2f(-1.4426950408889634f * v)); }
__device__ __forceinline__ float siluf_(float v) { return v * sigmoidf_(v); }
__device__ __forceinline__ float rs_from(unsigned ss, float inv_scale, float inv_n) { return __builtin_amdgcn_rsqf((float)ss * (inv_scale * inv_n) + EPS); }
__device__ __forceinline__ unsigned fixu(float v, float scale) { return (unsigned)(v * scale + 0.5f); }

namespace pg8 {
constexpr int BM = 256, BK = 64, HALF = 128, HTB = HALF * BK * 2, NXCD = 8, WGM = 4;
__host__ __device__ __forceinline__ int lds_byte(int r, int c) { const int st = (r >> 4) * 2 + (c >> 5), rr = r & 15, cc = c & 31, ob = rr * 64 + cc * 2; return st * 1024 + (ob ^ (((ob >> 9) & 1) << 5)); }
__host__ __device__ __forceinline__ void stage_rc(int b, int& R, int& C) { const int st = b / 1024, sb = b % 1024, swz = sb ^ (((sb >> 9) & 1) << 5); R = (st >> 1) * 16 + swz / 64; C = (st & 1) * 32 + (swz % 64) / 2; }
__host__ __device__ __forceinline__ int perm32(int rho) { const int n = rho >> 4, i = rho & 15; return 8 * (i >> 2) + 4 * n + (i & 3); }

typedef int i32x8 __attribute__((ext_vector_type(8)));
typedef int i32x4 __attribute__((ext_vector_type(4)));
typedef short s16x16 __attribute__((ext_vector_type(16)));
__device__ __forceinline__ i32x8 cat8(bf16x8 a, bf16x8 b) { return __builtin_bit_cast(i32x8, __builtin_shufflevector(a, b, 0, 1, 2, 3, 4, 5, 6, 7, 8, 9, 10, 11, 12, 13, 14, 15)); }
__device__ __forceinline__ bf16x8 lo8(i32x8 v) { return __builtin_bit_cast(bf16x8, __builtin_shufflevector(v, v, 0, 1, 2, 3)); }
__device__ __forceinline__ bf16x8 hi8(i32x8 v) { return __builtin_bit_cast(bf16x8, __builtin_shufflevector(v, v, 4, 5, 6, 7)); }
struct Unit { int pm, pn; long ao, bo; int aux; };
struct Gemm { const bf16_t* A; const bf16_t* Bt; int K, lda, ldb; };

struct StaticOrder {
    int nM, nN, nwg, G, c; long ta, tb;
    __device__ void init(int M, int N, int G_, int c_, int lda, int ldb) { nM = M / BM; nN = N / BM; nwg = nM * nN; G = G_; c = c_; ta = (long)BM * lda * 2; tb = (long)BM * ldb * 2; }
    __device__ bool next(int i, Unit& u) const {
        const long L = (long)i * G + c; if (L >= nwg) return false;
        int wgid = (int)L; { const int q = nwg / NXCD, r = nwg % NXCD, xcd = wgid % NXCD, off = wgid / NXCD; wgid = (xcd < r ? xcd * (q + 1) : r * (q + 1) + (xcd - r) * q) + off; }
        const int nig = WGM * nN, gid = wgid / nig, fm = gid * WGM, gsz = (nM - fm) < WGM ? (nM - fm) : WGM;
        u.pm = fm + ((wgid % nig) % gsz); u.pn = (wgid % nig) / gsz; u.ao = u.pm * ta; u.bo = u.pn * tb; u.aux = 0; return true;
    }
    __device__ __forceinline__ void a_ready(const Unit&) const {}
    __device__ __forceinline__ void done(const Unit&) const {}
};

template <class Epi, class Sched, bool ALIGN_EPI = false, int PREC = 0>
__device__ __forceinline__ void gemm_phase(LAS unsigned char* lds, const Gemm g, const Sched& S, const Epi& E, int wid) {
    const int lane = lane_id_(), tid = wid * 64 + lane, wr = wid >> 2, wc = wid & 3, fr = lane & 15, fq = lane >> 4;
    const int K = g.K, nt = K / BK;
    unsigned voffA[2], voffB[2];
#pragma unroll
    for (int i = 0; i < 2; ++i) { int R, C; stage_rc(tid * 16 + i * 8192, R, C); const int Rb = (R & ~31) + perm32(R & 31);
        voffA[i] = (unsigned)(R * g.lda + C) * 2u; voffB[i] = (unsigned)(Rb * g.ldb + C) * 2u; }
    const size_t kstep = (size_t)(BK * 2);
    const size_t hstepA = (size_t)HALF * g.lda * 2, hstepB = (size_t)HALF * g.ldb * 2;
    const unsigned ldsw = (unsigned)wid * 1024u;
    const int aoff = lds_byte(wr * 64 + fr, fq * 8), boff = lds_byte(wc * 32 + fr, fq * 8);
#define PG8_SA(b, h) (((b) * 2 + (h)) * HTB)
#define PG8_SB(b, h) ((4 + (b) * 2 + (h)) * HTB)
#define PG8_STAGE(bufoff, gbase, voff) do { _Pragma("unroll") for (int _i = 0; _i < 2; ++_i) \
        __builtin_amdgcn_global_load_lds((const unsigned*)((const char*)(gbase) + (voff)[_i]), (LAS unsigned*)(lds + (bufoff) + ldsw + _i * 8192), 16, 0, 0); } while (0)
#define PG8_LDA(dst, b, h) do { _Pragma("unroll") for (int m = 0; m < 4; ++m) { const bf16x8 f0_ = *(const LAS bf16x8*)(lds + PG8_SA(b, h) + aoff + m * 2048), f1_ = *(const LAS bf16x8*)(lds + PG8_SA(b, h) + aoff + m * 2048 + 1024); dst[m] = cat8(f0_, f1_); } } while (0)
#define PG8_LDB(dst, b, h) do { _Pragma("unroll") for (int n = 0; n < 2; ++n) { const bf16x8 f0_ = *(const LAS bf16x8*)(lds + PG8_SB(b, h) + boff + n * 2048), f1_ = *(const LAS bf16x8*)(lds + PG8_SB(b, h) + boff + n * 2048 + 1024); dst[n] = cat8(f0_, f1_); } } while (0)
#define PG8_MMA(ai, bj, At, Bt) do { __builtin_amdgcn_s_setprio(1); _Pragma("unroll") for (int m = 0; m < 4; ++m) _Pragma("unroll") for (int n = 0; n < 2; ++n) { \
        if constexpr (PREC == 1) { asm volatile("v_mfma_scale_f32_16x16x128_f8f6f4 %0, %1, %2, %0, %3, %3 op_sel_hi:[0,0,0]" : "+v"(acc[ai][bj][m][n]) : "v"(Bt[n]), "v"(At[m]), "v"(sc1)); } \
        else if constexpr (PREC == 2) { i32x4 c_ = __builtin_bit_cast(i32x4, acc[ai][bj][m][n]); \
               c_ = __builtin_amdgcn_mfma_i32_16x16x64_i8(__builtin_bit_cast(i32x4, lo8(Bt[n])), __builtin_bit_cast(i32x4, lo8(At[m])), c_, 0, 0, 0); \
               c_ = __builtin_amdgcn_mfma_i32_16x16x64_i8(__builtin_bit_cast(i32x4, hi8(Bt[n])), __builtin_bit_cast(i32x4, hi8(At[m])), c_, 0, 0, 0); acc[ai][bj][m][n] = __builtin_bit_cast(f32x4, c_); } \
        else { acc[ai][bj][m][n] = __builtin_amdgcn_mfma_f32_16x16x32_bf16(lo8(Bt[n]), lo8(At[m]), acc[ai][bj][m][n], 0, 0, 0); \
               acc[ai][bj][m][n] = __builtin_amdgcn_mfma_f32_16x16x32_bf16(hi8(Bt[n]), hi8(At[m]), acc[ai][bj][m][n], 0, 0, 0); } } \
        __builtin_amdgcn_s_setprio(0); } while (0)
#define PG8_WAIT_V(n) asm volatile("s_waitcnt vmcnt(" #n ")" ::: "memory")
#define PG8_WAIT_L(n) asm volatile("s_waitcnt lgkmcnt(" #n ")" ::: "memory")
#define PG8_BAR __builtin_amdgcn_s_barrier()
#define PG8_SCHED __builtin_amdgcn_sched_barrier(0)
    Unit cur, nxt; int ui = 0;
    if (!S.next(0, cur)) return;
    f32x4 acc[2][2][4][2];
#pragma unroll
    for (int a = 0; a < 2; ++a)
#pragma unroll
        for (int b = 0; b < 2; ++b)
#pragma unroll
            for (int m = 0; m < 4; ++m)
#pragma unroll
                for (int n = 0; n < 2; ++n) acc[a][b][m][n] = (f32x4){0.f, 0.f, 0.f, 0.f};
    i32x8 At[4], B0[2], B1[2]; const unsigned sc1 = 0x7f7f7f7fu;
    const char* cA = (const char*)g.A + cur.ao; const char* cB = (const char*)g.Bt + cur.bo;
    S.a_ready(cur);
    PG8_STAGE(PG8_SB(0, 0), cB, voffB); PG8_STAGE(PG8_SB(0, 1), cB + hstepB, voffB); PG8_STAGE(PG8_SA(0, 0), cA, voffA); PG8_STAGE(PG8_SA(0, 1), cA + hstepA, voffA);
    if (wr == 1) PG8_BAR;
    PG8_WAIT_V(2); PG8_BAR;
    PG8_STAGE(PG8_SB(1, 0), cB + kstep, voffB); PG8_STAGE(PG8_SA(1, 0), cA + kstep, voffA); PG8_STAGE(PG8_SB(1, 1), cB + hstepB + kstep, voffB);
    PG8_WAIT_V(6); PG8_BAR;
    for (;;) {
        const bool has_next = S.next(ui + 1, nxt);
        const char* nA = has_next ? (const char*)g.A + nxt.ao : cA; const char* nB = has_next ? (const char*)g.Bt + nxt.bo : cB;
        int tb = 0;
#pragma unroll 1
        for (int seg = 0; seg < (Epi::MID_TILE > 0 ? 2 : 1); ++seg) {
        const int te = (Epi::MID_TILE > 0 && seg == 0) ? Epi::MID_TILE : nt;
        if constexpr (Epi::MID_TILE > 0) { if (seg == 1) { PG8_SCHED; E.mid(acc, cur, wr, fr); PG8_SCHED; } }
#pragma unroll 1
        for (int t = tb; t < te; t += 2) {
            const bool last = (t == nt - 2);
            const char* a1 = cA + (size_t)(t + 1) * kstep;
            const char* a2 = last ? nA : cA + (size_t)(t + 2) * kstep; const char* b2 = last ? nB : cB + (size_t)(t + 2) * kstep;
            const char* a3 = a2 + kstep; const char* b3 = b2 + kstep;
            if (last && has_next) S.a_ready(nxt);
            PG8_LDB(B0, 0, 0); PG8_LDB(B1, 0, 1); PG8_SCHED; PG8_LDA(At, 0, 0); PG8_STAGE(PG8_SA(1, 1), a1 + hstepA, voffA);
            PG8_WAIT_V(8); PG8_WAIT_L(0); PG8_BAR; PG8_MMA(0, 0, At, B0); PG8_MMA(0, 1, At, B1); PG8_BAR; PG8_SCHED;
            PG8_LDA(At, 0, 1); PG8_STAGE(PG8_SB(0, 0), b2, voffB); PG8_STAGE(PG8_SB(0, 1), b2 + hstepB, voffB); PG8_STAGE(PG8_SA(0, 0), a2, voffA);
            PG8_WAIT_V(8); PG8_WAIT_L(0); PG8_BAR; PG8_MMA(1, 0, At, B0); PG8_MMA(1, 1, At, B1); PG8_BAR; PG8_SCHED;
            PG8_LDB(B0, 1, 0); PG8_LDB(B1, 1, 1); PG8_SCHED; PG8_LDA(At, 1, 0); PG8_STAGE(PG8_SA(0, 1), a2 + hstepA, voffA);
            PG8_WAIT_V(8); PG8_WAIT_L(0); PG8_BAR; PG8_MMA(0, 0, At, B0); PG8_MMA(0, 1, At, B1); PG8_BAR; PG8_SCHED;
            PG8_LDA(At, 1, 1); PG8_STAGE(PG8_SB(1, 0), b3, voffB); PG8_STAGE(PG8_SB(1, 1), b3 + hstepB, voffB); PG8_STAGE(PG8_SA(1, 0), a3, voffA);
            PG8_WAIT_V(8); PG8_WAIT_L(0); PG8_BAR; PG8_MMA(1, 0, At, B0); PG8_MMA(1, 1, At, B1); PG8_BAR; PG8_SCHED;
        }
        tb = te;
        }
        if constexpr (ALIGN_EPI) { if (wr == 0) PG8_BAR; }
        if constexpr (PREC == 1) asm volatile("s_nop 15\n\ts_nop 15" ::: "memory");
        if constexpr (PREC == 2) {
#pragma unroll
            for (int a = 0; a < 2; ++a)
#pragma unroll
                for (int b = 0; b < 2; ++b)
#pragma unroll
                    for (int m = 0; m < 4; ++m)
#pragma unroll
                        for (int n = 0; n < 2; ++n) acc[a][b][m][n] = __builtin_convertvector(__builtin_bit_cast(i32x4, acc[a][b][m][n]), f32x4); }
        E(acc, cur, wr, wc, fr, fq); S.done(cur);
        if (!has_next) break;
#pragma unroll
        for (int a = 0; a < 2; ++a)
#pragma unroll
            for (int b = 0; b < 2; ++b)
#pragma unroll
                for (int m = 0; m < 4; ++m)
#pragma unroll
                    for (int n = 0; n < 2; ++n) acc[a][b][m][n] = (f32x4){0.f, 0.f, 0.f, 0.f};
        cur = nxt; cA = nA; cB = nB; ++ui;
        if constexpr (ALIGN_EPI) { if (wr == 1) PG8_BAR; }
    }
    PG8_WAIT_V(0);
    if constexpr (!ALIGN_EPI) { if (wr == 0) PG8_BAR; }
    PG8_BAR;
#undef PG8_SA
#undef PG8_SB
#undef PG8_STAGE
#undef PG8_LDA
#undef PG8_LDB
#undef PG8_MMA
#undef PG8_WAIT_V
#undef PG8_WAIT_L
#undef PG8_BAR
#undef PG8_SCHED
}

typedef const f32x4 (&AccRef)[2][2][4][2];

struct EpiSwiGLU {
    static constexpr int MID_TILE = 0;
    unsigned char* O; const unsigned* ss; const float* rowf; float cf;
    __device__ __forceinline__ void mid(f32x4 (&)[2][2][4][2], const Unit&, int, int) const {}
    __device__ __forceinline__ void operator()(AccRef acc, const Unit& u, int wr, int wc, int fr, int fq) const {
        int row0 = u.pm * BM + wr * 64 + fr; asm volatile("" : "+v"(row0)); const int col0 = u.pn * 128 + wc * 32 + 8 * fq;
        unsigned sv[8];
#pragma unroll
        for (int q = 0; q < 8; ++q) sv[q] = ss[row0 + (q >> 2) * HALF + (q & 3) * 16];
        asm volatile("" ::: "memory");
#pragma unroll
        for (int ai = 0; ai < 2; ++ai)
#pragma unroll
            for (int m = 0; m < 4; ++m) { const int row = row0 + ai * HALF + m * 16; const float r = rs_from(sv[ai * 4 + m], SSX_INV, 1.f / DM) * cf * (rowf ? rowf[row] : 1.f);
                float o[8];
#pragma unroll
                for (int n = 0; n < 2; ++n)
#pragma unroll
                    for (int e = 0; e < 4; ++e) { const float gv = acc[ai][0][m][n][e] * r, uv = acc[ai][1][m][n][e] * r; o[4 * n + e] = siluf_(gv) * uv; }
                *(u32x2*)(O + (size_t)row * FFP + col0) = pk8_fp8(o); }
    }
};

template <int MODE> struct EpiResid {
    static constexpr int MID_TILE = MODE == 1 ? (OUT_FP8 ? CCH / 128 : CCH / BK) : 0;
    const float* xf; bf16_t* xb; unsigned char* x8; unsigned* ss; const unsigned* ssc; const unsigned* ssn;
    __device__ __forceinline__ void mid(f32x4 (&acc)[2][2][4][2], const Unit& u, int wr, int fr) const {
        if constexpr (MODE == 1) {
            int row0 = u.pm * BM + wr * 64 + fr; asm volatile("" : "+v"(row0));
#pragma unroll
            for (int ai = 0; ai < 2; ++ai)
#pragma unroll
                for (int m = 0; m < 4; ++m) { const int row = row0 + ai * HALF + m * 16;
                    const float f = rs_from(ssc[row], SSC_INV, 1.f / CCH) * __builtin_amdgcn_sqrtf((float)ssn[row] * (SSN_INV / (NH * HD)) + EPS) * (OUT_FP8 ? A8N / A8C : 1.f);
#pragma unroll
                    for (int bj = 0; bj < 2; ++bj)
#pragma unroll
                        for (int n = 0; n < 2; ++n) acc[ai][bj][m][n] *= f;
                    __builtin_amdgcn_sched_barrier(0); }
        }
    }
    __device__ __forceinline__ void operator()(AccRef acc, const Unit& u, int wr, int wc, int fr, int fq) const {
        int row0 = u.pm * BM + wr * 64 + fr; asm volatile("" : "+v"(row0)); const int col0 = u.pn * BM + wc * 32 + 8 * fq;
#pragma unroll
        for (int ai = 0; ai < 2; ++ai) {
            f32x4 xv[4][2][2]; float scv[4];
#pragma unroll
            for (int m = 0; m < 4; ++m) { const int row = row0 + ai * HALF + m * 16;
                scv[m] = W8S_INV; if constexpr (MODE == 1) scv[m] = rs_from(ssn[row], SSN_INV, 1.f / (NH * HD)) * (OUT_FP8 ? W8S_INV / A8N : 1.f);
#pragma unroll
                for (int bj = 0; bj < 2; ++bj) { const size_t idx = (size_t)row * DM + col0 + bj * HALF;
                    if constexpr (MODE == 0) { xv[m][bj][0] = *(const f32x4*)(xf + idx); xv[m][bj][1] = *(const f32x4*)(xf + idx + 4); }
                    else { const u32x4 w = *(const u32x4*)(xb + idx); xv[m][bj][0] = (f32x4){bflo(w.x), bfhi(w.x), bflo(w.y), bfhi(w.y)}; xv[m][bj][1] = (f32x4){bflo(w.z), bfhi(w.z), bflo(w.w), bfhi(w.w)}; } } }
            asm volatile("" ::: "memory");
#pragma unroll
            for (int m = 0; m < 4; ++m) { const int row = row0 + ai * HALF + m * 16; const float sc = scv[m];
                float sq = 0.f;
#pragma unroll
                for (int bj = 0; bj < 2; ++bj) { const size_t idx = (size_t)row * DM + col0 + bj * HALF;
                    const f32x4 y0 = xv[m][bj][0] + acc[ai][bj][m][0] * sc, y1 = xv[m][bj][1] + acc[ai][bj][m][1] * sc;
                    { u32x4 w; w.x = cvtpk(y0[0], y0[1]); w.y = cvtpk(y0[2], y0[3]); w.z = cvtpk(y1[0], y1[1]); w.w = cvtpk(y1[2], y1[3]); *(u32x4*)(xb + idx) = w; }
                    if constexpr (MODE != 2) { const float yv[8] = {y0[0], y0[1], y0[2], y0[3], y1[0], y1[1], y1[2], y1[3]}; *(u32x2*)(x8 + idx) = pk8_i8(yv, MODE == 0 ? SA1 : SA2); }
                    sq += (y0[0] * y0[0] + y0[1] * y0[1]) + (y0[2] * y0[2] + y0[3] * y0[3]) + (y1[0] * y1[0] + y1[1] * y1[1]) + (y1[2] * y1[2] + y1[3] * y1[3]); }
                sq += __shfl_xor(sq, 16); sq += __shfl_xor(sq, 32);
                if (fq == 0) atomicAdd(ss + row, fixu(sq, SSX)); }
        }
    }
};

struct EpiPw {
    static constexpr int MID_TILE = 0;
    void* O; unsigned* ssc;
    __device__ __forceinline__ void mid(f32x4 (&)[2][2][4][2], const Unit&, int, int) const {}
    __device__ __forceinline__ void operator()(AccRef acc, const Unit& u, int wr, int wc, int fr, int fq) const {
        int row0 = u.pm * BM + wr * 64 + fr; asm volatile("" : "+v"(row0)); const int col0 = u.pn * BM + wc * 32 + 8 * fq;
#pragma unroll
        for (int ai = 0; ai < 2; ++ai)
#pragma unroll
            for (int m = 0; m < 4; ++m) { const int row = row0 + ai * HALF + m * 16; float sq = 0.f;
#pragma unroll
                for (int bj = 0; bj < 2; ++bj) { const f32x4 y0 = acc[ai][bj][m][0], y1 = acc[ai][bj][m][1];
                    if constexpr (OUT_FP8) { const float yv[8] = {y0[0] * A8C, y0[1] * A8C, y0[2] * A8C, y0[3] * A8C, y1[0] * A8C, y1[1] * A8C, y1[2] * A8C, y1[3] * A8C};
                        *(u32x2*)((unsigned char*)O + (size_t)row * DM + col0 + bj * HALF) = pk8_fp8(yv); }
                    else { u32x4 w; w.x = cvtpk(y0[0], y0[1]); w.y = cvtpk(y0[2], y0[3]); w.z = cvtpk(y1[0], y1[1]); w.w = cvtpk(y1[2], y1[3]);
                        *(u32x4*)((bf16_t*)O + (size_t)row * DM + col0 + bj * HALF) = w; }
                    sq += (y0[0] * y0[0] + y0[1] * y0[1]) + (y0[2] * y0[2] + y0[3] * y0[3]) + (y1[0] * y1[0] + y1[1] * y1[1]) + (y1[2] * y1[2] + y1[3] * y1[3]); }
                sq += __shfl_xor(sq, 16); sq += __shfl_xor(sq, 32);
                if (fq == 0) atomicAdd(ssc + row, fixu(sq, SSC)); }
    }
};

struct EpiCmpPart {
    static constexpr int MID_TILE = 0;
    float* P;
    __device__ __forceinline__ void mid(f32x4 (&)[2][2][4][2], const Unit&, int, int) const {}
    __device__ __forceinline__ void operator()(AccRef acc, const Unit& u, int wr, int wc, int fr, int fq) const {
        int row0 = u.pm * BM + wr * 64 + fr; asm volatile("" : "+v"(row0)); const int col0 = wc * 32 + 8 * fq; float* base = P + (size_t)u.aux * (12 * NCP) * 256;
#pragma unroll
        for (int ai = 0; ai < 2; ++ai)
#pragma unroll
            for (int m = 0; m < 4; ++m) { float* rowp = base + (size_t)(row0 + ai * HALF + m * 16) * 256 + col0;
#pragma unroll
                for (int bj = 0; bj < 2; ++bj) { *(f32x4*)(rowp + bj * HALF) = acc[ai][bj][m][0]; *(f32x4*)(rowp + bj * HALF + 4) = acc[ai][bj][m][1]; } }
    }
};
struct CmpOrder {
    int G, c; long akv;
    __device__ bool next(int i, Unit& u) const {
        const int L = i * G + c; if (L >= 192) return false;
        const int kv = L / 96, r = L % 96, ks = r / 24, pm = r % 24;
        u.pm = pm; u.pn = 0; u.aux = kv * 4 + ks;
        u.ao = kv * akv + ((long)pm * 256 * 2048 + ks * 1024) * 2; u.bo = ((long)kv * 256 * 4096 + ks * 1024) * 2; return true;
    }
    __device__ __forceinline__ void a_ready(const Unit&) const {}
    __device__ __forceinline__ void done(const Unit&) const {}
};

struct EpiWin {
    static constexpr int MID_TILE = 0;
    const unsigned* ss;
    bf16_t *QRAW, *QROT, *KC, *VC, *KS, *VS, *KW, *VW, *U; float* G;
    __device__ __forceinline__ void mid(f32x4 (&)[2][2][4][2], const Unit&, int, int) const {}
    __device__ __forceinline__ void operator()(AccRef acc, const Unit& u, int wr, int wc, int fr, int fq) const {
        int row0 = u.pm * BM + wr * 64 + fr; asm volatile("" : "+v"(row0)); const int pn = u.pn;
        float invr[8];
#pragma unroll
        for (int j = 0; j < 8; ++j) invr[j] = exp2f(-(float)(32 * (wc & 1) + 8 * fq + j) * (13.287712379549449f / 64.f)) * 0.15915494309189535f;
        unsigned sv[8];
#pragma unroll
        for (int q = 0; q < 8; ++q) sv[q] = ss[row0 + (q >> 2) * HALF + (q & 3) * 16];
        asm volatile("" ::: "memory");
#pragma unroll
        for (int ai = 0; ai < 2; ++ai)
#pragma unroll
            for (int m = 0; m < 4; ++m) { const int row = row0 + ai * HALF + m * 16; const float r = rs_from(sv[ai * 4 + m], SSX_INV, 1.f / DM) * (SW8_INV / SA1);
                const int bb = row >> 13, s = row & (SEQ - 1);
                float a0[8], a1[8];
#pragma unroll
                for (int n = 0; n < 2; ++n)
#pragma unroll
                    for (int e = 0; e < 4; ++e) { a0[4 * n + e] = acc[ai][0][m][n][e] * r; a1[4 * n + e] = acc[ai][1][m][n][e] * r; }
                if (pn < 6) {
                    const int idx0 = 32 * (wc & 1) + 8 * fq; const int head = 2 * pn + (wc >> 1); const size_t qi = ((size_t)row * NH + head) * HD + idx0;
                    u32x4 r1, r2; r1.x = cvtpk(a0[0], a0[1]); r1.y = cvtpk(a0[2], a0[3]); r1.z = cvtpk(a0[4], a0[5]); r1.w = cvtpk(a0[6], a0[7]);
                    r2.x = cvtpk(a1[0], a1[1]); r2.y = cvtpk(a1[2], a1[3]); r2.z = cvtpk(a1[4], a1[5]); r2.w = cvtpk(a1[6], a1[7]);
                    *(u32x4*)(QRAW + qi) = r1; *(u32x4*)(QRAW + qi + 64) = r2;
                } else if (pn < 9) {
                    const int idx0 = 32 * (wc & 1) + 8 * fq;
                    float o1[8], o2[8]; const float sf = (float)s;
#pragma unroll
                    for (int j = 0; j < 8; ++j) {
                        const float fr = __builtin_amdgcn_fractf(sf * invr[j]); const float cc = __builtin_amdgcn_cosf(fr), sn = __builtin_amdgcn_sinf(fr);
                        o1[j] = a0[j] * cc - a1[j] * sn; o2[j] = a1[j] * cc + a0[j] * sn; }
                    { const int rh = 2 * (pn - 6) + (wc >> 1); unsigned char* dst = (unsigned char*)(rh < 3 ? KS : KW); const int kvh = rh < 3 ? rh : rh - 3;
                        const size_t ki = (((size_t)bb * NKV + kvh) * SEQ + s) * HD + idx0;
                        *(u32x2*)(dst + ki) = pk8_fp8(o1); *(u32x2*)(dst + ki + 64) = pk8_fp8(o2); }
                } else if (pn < 15) {
                    u32x4 w0, w1; w0.x = cvtpk(a0[0], a0[1]); w0.y = cvtpk(a0[2], a0[3]); w0.z = cvtpk(a0[4], a0[5]); w0.w = cvtpk(a0[6], a0[7]);
                    w1.x = cvtpk(a1[0], a1[1]); w1.y = cvtpk(a1[2], a1[3]); w1.z = cvtpk(a1[4], a1[5]); w1.w = cvtpk(a1[6], a1[7]);
                    const int col = 32 * wc + 8 * fq;
#pragma unroll
                    for (int bj = 0; bj < 2; ++bj) { const int ph = 2 * (pn - 9) + bj, tn = ph / 3, kvh = ph % 3;
                        bf16_t* dst = tn == 0 ? KC : (tn == 1 ? VC : (tn == 2 ? VS : VW));
                        *(u32x4*)(dst + (((size_t)bb * NKV + kvh) * SEQ + s) * HD + col) = bj ? w1 : w0; }
                } else if (pn < 19) {
                    float o[8];
#pragma unroll
                    for (int j = 0; j < 8; ++j) o[j] = a0[j] * sigmoidf_(a1[j]);
                    u32x4 w; w.x = cvtpk(o[0], o[1]); w.y = cvtpk(o[2], o[3]); w.z = cvtpk(o[4], o[5]); w.w = cvtpk(o[6], o[7]);
                    *(u32x4*)(U + (size_t)row * CCH + 128 * (pn - 15) + 32 * wc + 8 * fq) = w;
                } else {
                    const int col = 32 * wc + 8 * fq;
                    if (col < GLD) { f32x4 g0, g1;
#pragma unroll
                        for (int j = 0; j < 4; ++j) { g0[j] = sigmoidf_(a0[j]); g1[j] = sigmoidf_(a0[4 + j]); }
                        *(f32x4*)(G + (size_t)row * GLD + col) = g0; *(f32x4*)(G + (size_t)row * GLD + col + 4) = g1; }
                }
            }
    }
};
}

namespace att {
constexpr int SHM_K = 16384, SHM_V = 16384;
constexpr int L_V = 0, L_K = 32768, L_WS = 65536, L_IMP = 67584, L_OACC = 67584, L_SEL = 133120;
constexpr float SCALE = 0.08838834764831845f;
constexpr float THR = 5.5f;
#define KSWZ(row, colB) ((row) * 256 + ((colB) ^ (((row) & 7) << 4)))
__device__ __forceinline__ int v_st(int k, int c) { const int kk = (k & ~0xC) | ((k & 4) << 1) | ((k & 8) >> 1); return ((kk >> 3) * 4 + (c >> 5)) * 512 + ((kk & 7) * 32 + (c & 31)) * 2; }
__device__ __forceinline__ int v_rd_base(int lane) { return ((lane & 3) << 3) | (((lane >> 2) & 3) << 6) | (((lane >> 4) & 1) << 5) | (((lane >> 5) & 1) << 8); }
constexpr int v_rd_off(int d0, int ks, int half) { return d0 * 512 + ks * 4096 + half * 2048; }
__device__ __forceinline__ int crow(int r, int hi) { return (r & 3) + 8 * (r >> 2) + 4 * hi; }

__device__ __forceinline__ void mask_tile(f32x16& p0, f32x16& p1, int dq, unsigned W) {
    const float NEG = -__builtin_inff();
#pragma unroll
    for (int r = 0; r < 16; ++r) {
        const int c = (r & 3) + 8 * (r >> 2);
        if ((unsigned)(dq - c) >= W) p0[r] = NEG;
        if ((unsigned)(dq - c - 32) >= W) p1[r] = NEG;
    }
}
__device__ __forceinline__ void partialSM(f32x16& p0, f32x16& p1, float& m_reg, float& mn, float& alpha, bool sel = true) {
    float pmax = p0[0];
#pragma unroll
    for (int r = 1; r < 16; ++r) pmax = fmaxf(pmax, p0[r]);
#pragma unroll
    for (int r = 0; r < 16; ++r) pmax = fmaxf(pmax, p1[r]);
    { auto rr = __builtin_amdgcn_permlane32_swap(__float_as_uint(pmax), __float_as_uint(pmax), false, false);
      pmax = fmaxf(__uint_as_float(rr[0]), __uint_as_float(rr[1])); }
    constexpr float C2 = 1.4426950408889634f * SCALE;
    pmax = sel ? pmax : -__builtin_inff();
    if (__builtin_expect(__all((pmax - m_reg) * SCALE <= THR), 1)) { mn = m_reg; alpha = 1.f; }
    else { mn = fmaxf(m_reg, pmax); alpha = __builtin_amdgcn_exp2f((m_reg - mn) * C2); m_reg = mn; }
    const float mnL = sel ? -mn * C2 : -__builtin_inff();
#pragma unroll
    for (int r = 0; r < 16; ++r) p0[r] = fmaf(p0[r], C2, mnL);
#pragma unroll
    for (int r = 0; r < 16; ++r) p1[r] = fmaf(p1[r], C2, mnL);
#pragma unroll
    for (int r = 0; r < 16; ++r) p0[r] = __builtin_amdgcn_exp2f(p0[r]);
}
#define PK4(P, B_, OUT) do { unsigned a0 = cvtpk(P[B_+0], P[B_+1]), a1 = cvtpk(P[B_+2], P[B_+3]);                          \
        unsigned b0 = cvtpk(P[B_+4], P[B_+5]), b1 = cvtpk(P[B_+6], P[B_+7]);                                             \
        auto r0 = __builtin_amdgcn_permlane32_swap(a0, b0, false, false); auto r1 = __builtin_amdgcn_permlane32_swap(a1, b1, false, false); \
        u32x4 w = {r0[0], r1[0], r0[1], r1[1]}; OUT = *reinterpret_cast<bf16x8*>(&w); } while (0)
__device__ __forceinline__ void finishSM(f32x16& p0, f32x16& p1, float alpha, float& l_reg, bf16x8& pa0, bf16x8& pa1, bf16x8& pa2, bf16x8& pa3) {
#pragma unroll
    for (int r = 0; r < 16; ++r) p1[r] = __builtin_amdgcn_exp2f(p1[r]);
    float ps = 0;
#pragma unroll
    for (int r = 0; r < 16; ++r) ps += p0[r];
#pragma unroll
    for (int r = 0; r < 16; ++r) ps += p1[r];
    { auto rr = __builtin_amdgcn_permlane32_swap(__float_as_uint(ps), __float_as_uint(ps), false, false);
      ps = __uint_as_float(rr[0]) + __uint_as_float(rr[1]); }
    l_reg = l_reg * alpha + ps;
    PK4(p0, 0, pa0); PK4(p0, 8, pa1); PK4(p1, 0, pa2); PK4(p1, 8, pa3);
}
__device__ __forceinline__ void finishStats(f32x16& p0, f32x16& p1, float alpha, float& l_reg) {
#pragma unroll
    for (int r = 0; r < 16; ++r) p1[r] = __builtin_amdgcn_exp2f(p1[r]);
    float ps = 0;
#pragma unroll
    for (int r = 0; r < 16; ++r) ps += p0[r];
#pragma unroll
    for (int r = 0; r < 16; ++r) ps += p1[r];
    { auto rr = __builtin_amdgcn_permlane32_swap(__float_as_uint(ps), __float_as_uint(ps), false, false);
      ps = __uint_as_float(rr[0]) + __uint_as_float(rr[1]); }
    l_reg = l_reg * alpha + ps;
}
template <int KB>
__device__ __forceinline__ void qkt(f32x16& p0, f32x16& p1, LAS const char* K_lds, int r32, int hi, const bf16x8* qr) {
    p0 = f32x16{}; p1 = f32x16{};
    asm volatile("" : "+v"(r32));
    unsigned kb[4];
#pragma unroll
    for (int dd = 0; dd < 4; ++dd) kb[dd] = (unsigned)(uintptr_t)(K_lds + KB * SHM_K + KSWZ(r32, (dd * 16 + hi * 8) * 2));
#define KRD(dst, a, off) asm volatile("ds_read_b128 %0, %1 offset:%2" : "=v"(dst) : "v"(a), "i"(off) : "memory")
    bf16x8 f0, g0, f1, g1;
    KRD(f0, kb[0], 0); KRD(g0, kb[0], 8192); KRD(f1, kb[1], 0); KRD(g1, kb[1], 8192);
#define QK_STEP(d0, F, G, WAITN) do { asm volatile("s_waitcnt lgkmcnt(" #WAITN ")" ::: "memory"); SBAR(); \
        p0 = __builtin_amdgcn_mfma_f32_32x32x16_bf16(F, qr[d0], p0, 0, 0, 0); p1 = __builtin_amdgcn_mfma_f32_32x32x16_bf16(G, qr[d0], p1, 0, 0, 0); SBAR(); \
        if ((d0) + 2 < 8) { KRD(F, kb[((d0) + 2) & 3], (((d0) + 2) >> 2) * 128); KRD(G, kb[((d0) + 2) & 3], (((d0) + 2) >> 2) * 128 + 8192); } SBAR(); } while (0)
    QK_STEP(0, f0, g0, 2); QK_STEP(1, f1, g1, 2); QK_STEP(2, f0, g0, 2); QK_STEP(3, f1, g1, 2); QK_STEP(4, f0, g0, 2); QK_STEP(5, f1, g1, 2); QK_STEP(6, f0, g0, 2); QK_STEP(7, f1, g1, 0);
#undef QK_STEP
#undef KRD
}
template <int VB>
__device__ __forceinline__ void pv_tile(f32x16* o, int vb0, bf16x8 pa0, bf16x8 pa1, bf16x8 pa2, bf16x8 pa3) {
#define TRRD(dst, off) asm volatile("ds_read_b64_tr_b16 %0, %1 offset:%2" : "=&v"(dst) : "v"(vb0), "i"(off) : "memory")
#define PV_RD(i, L, H) do { constexpr int b_ = VB * SHM_V + v_rd_off((i) >> 2, (i) & 3, 0); TRRD(L, b_); TRRD(H, b_ + 2048); } while (0)
#define PV_MM(i, PA, L, H, WAITN) do { asm volatile("s_waitcnt lgkmcnt(" #WAITN ")" ::: "memory"); SBAR(); \
        o[(i) >> 2] = __builtin_amdgcn_mfma_f32_32x32x16_bf16(PA, (bf16x8){L[0], L[1], L[2], L[3], H[0], H[1], H[2], H[3]}, o[(i) >> 2], 0, 0, 0); SBAR(); \
        if ((i) + 4 < 16) PV_RD((i) + 4, L, H); SBAR(); } while (0)
    s16x4 l0, l1, l2, l3, h0, h1, h2, h3;
    PV_RD(0, l0, h0); PV_RD(1, l1, h1); PV_RD(2, l2, h2); PV_RD(3, l3, h3);
    PV_MM(0, pa0, l0, h0, 6); PV_MM(1, pa1, l1, h1, 6); PV_MM(2, pa2, l2, h2, 6); PV_MM(3, pa3, l3, h3, 6);
    PV_MM(4, pa0, l0, h0, 6); PV_MM(5, pa1, l1, h1, 6); PV_MM(6, pa2, l2, h2, 6); PV_MM(7, pa3, l3, h3, 6);
    PV_MM(8, pa0, l0, h0, 6); PV_MM(9, pa1, l1, h1, 6); PV_MM(10, pa2, l2, h2, 6); PV_MM(11, pa3, l3, h3, 6);
    PV_MM(12, pa0, l0, h0, 6); PV_MM(13, pa1, l1, h1, 4); PV_MM(14, pa2, l2, h2, 2); PV_MM(15, pa3, l3, h3, 0);
#undef PV_MM
#undef PV_RD
#undef TRRD
}

struct AttnP { const bf16_t *QRAW, *KCMP, *VCMP; const unsigned char *KS8, *KW8, *VTS, *VTW; const float* G; void* MIXED; unsigned* ssn; };

#define MFMA16(ACC, A, B) asm volatile("v_mfma_scale_f32_16x16x128_f8f6f4 %0, %1, %2, %0, %3, %3 op_sel_hi:[0,0,0]" : "+v"(ACC) : "v"(A), "v"(B), "v"(0x7f7f7f7fu))
#define MFMA16C(D, A, B, C, SA) asm volatile("v_mfma_scale_f32_16x16x128_f8f6f4 %0, %1, %2, %3, %4, %5 op_sel_hi:[0,0,0]" : "=&v"(D) : "v"(A), "v"(B), "v"(C), "v"(SA), "v"(0x7f7f7f7fu))
#define MFMA_DONE() asm volatile("s_nop 11" ::: "memory")
#define MFMA_PRE() asm volatile("s_nop 1" ::: "memory")
#define RD128(dst, a, off) asm volatile("ds_read_b128 %0, %1 offset:%2" : "=v"(dst) : "v"(a), "i"(off) : "memory")
#define LGK(n) asm volatile("s_waitcnt lgkmcnt(" #n ")" ::: "memory")
typedef int i32x8_t __attribute__((ext_vector_type(8)));
typedef int i32x4_t __attribute__((ext_vector_type(4)));
__device__ __forceinline__ i32x8_t cat88(i32x4_t a, i32x4_t b) { return __builtin_shufflevector(a, b, 0, 1, 2, 3, 4, 5, 6, 7); }
template <int CASE>
__device__ __forceinline__ void qk_half(f32x4 (&s0)[4], f32x4 (&s1)[4], const unsigned ka0, const unsigned ka1, const i32x8_t (&Qf)[2], const f32x4 (&cv)[2]) {
    const unsigned sk = 0x7c7c7c7cu;
    i32x4_t a0l, a0h, a1l, a1h;
    RD128(a0l, ka0, 0); RD128(a0h, ka1, 0); RD128(a1l, ka0, 2048); RD128(a1h, ka1, 2048);
#define QK_(m, lo, hi_) do { const i32x8_t K_ = cat88(lo, hi_); if constexpr (CASE & 1) MFMA16C(s0[m], K_, Qf[0], cv[0], sk); if constexpr (CASE & 2) MFMA16C(s1[m], K_, Qf[1], cv[1], sk); } while (0)
    LGK(2); SBAR(); MFMA_PRE(); QK_(0, a0l, a0h); SBAR(); RD128(a0l, ka0, 4096); RD128(a0h, ka1, 4096); LGK(2); SBAR(); QK_(1, a1l, a1h); SBAR(); RD128(a1l, ka0, 6144); RD128(a1h, ka1, 6144);
    LGK(2); SBAR(); QK_(2, a0l, a0h); SBAR(); LGK(0); SBAR(); QK_(3, a1l, a1h); SBAR(); MFMA_DONE();
#undef QK_
}
template <int CASE>
__device__ __forceinline__ void pv_step(f32x4 (&o0)[8], f32x4 (&o1)[8], const unsigned va0, const unsigned va1, const i32x8_t (&P8)[2]) {
    i32x4_t a0l, a0h, a1l, a1h;
#define PV_(db, lo, hi_) do { const i32x8_t V_ = cat88(lo, hi_); if constexpr (CASE & 1) MFMA16(o0[db], V_, P8[0]); if constexpr (CASE & 2) MFMA16(o1[db], V_, P8[1]); } while (0)
    RD128(a0l, va0, 0); RD128(a0h, va1, 0); RD128(a1l, va0, 2048); RD128(a1h, va1, 2048);
    MFMA_PRE();
#pragma unroll
    for (int q = 0; q < 3; ++q) {
        LGK(2); SBAR(); PV_(2 * q, a0l, a0h); SBAR(); RD128(a0l, va0, (2 * q + 2) * 2048); RD128(a0h, va1, (2 * q + 2) * 2048);
        LGK(2); SBAR(); PV_(2 * q + 1, a1l, a1h); SBAR(); RD128(a1l, va0, (2 * q + 3) * 2048); RD128(a1h, va1, (2 * q + 3) * 2048); }
    LGK(2); SBAR(); PV_(6, a0l, a0h); SBAR(); LGK(0); SBAR(); PV_(7, a1l, a1h); SBAR(); MFMA_DONE();
#undef PV_
}
__device__ __forceinline__ void mask16(f32x4 (&s)[4], const int dq, const unsigned W) {
#pragma unroll
    for (int m = 0; m < 4; ++m)
#pragma unroll
        for (int e = 0; e < 4; ++e) if ((unsigned)(dq - 16 * m - e) >= W) s[m][e] = -__builtin_inff();
}
__device__ __forceinline__ float max16(const f32x4 (&s)[4]) {
    float a = fmaxf(fmaxf(s[0][0], s[0][1]), s[0][2]), b = fmaxf(fmaxf(s[0][3], s[1][0]), s[1][1]);
    a = fmaxf(fmaxf(a, s[1][2]), s[1][3]); b = fmaxf(fmaxf(b, s[2][0]), s[2][1]); a = fmaxf(fmaxf(a, s[2][2]), s[2][3]); b = fmaxf(fmaxf(b, s[3][0]), s[3][1]);
    return fmaxf(fmaxf(fmaxf(a, s[3][2]), s[3][3]), b);
}
__device__ __forceinline__ i32x4_t exp_pack16(f32x4 (&s)[4], const bool sel, float& l) {
    float t0, t1, t2, t3;
    asm volatile("v_exp_f32 %4, %4\n\tv_exp_f32 %5, %5\n\tv_exp_f32 %6, %6\n\tv_exp_f32 %7, %7\n\tv_exp_f32 %8, %8\n\tv_exp_f32 %9, %9\n\tv_exp_f32 %10, %10\n\tv_exp_f32 %11, %11\n\t"
                 "v_exp_f32 %12, %12\n\tv_exp_f32 %13, %13\n\tv_exp_f32 %14, %14\n\tv_exp_f32 %15, %15\n\tv_exp_f32 %16, %16\n\tv_exp_f32 %17, %17\n\tv_exp_f32 %18, %18\n\tv_exp_f32 %19, %19\n\t"
                 "v_add_f32 %0, %4, %5\n\tv_add_f32 %1, %6, %7\n\tv_add_f32 %2, %8, %9\n\tv_add_f32 %3, %10, %11\n\t"
                 "v_add_f32 %0, %0, %12\n\tv_add_f32 %1, %1, %13\n\tv_add_f32 %2, %2, %14\n\tv_add_f32 %3, %3, %15\n\t"
                 "v_add_f32 %0, %0, %16\n\tv_add_f32 %1, %1, %17\n\tv_add_f32 %2, %2, %18\n\tv_add_f32 %3, %3, %19\n\t"
                 "v_add_f32 %0, %0, %1\n\tv_add_f32 %2, %2, %3\n\tv_add_f32 %0, %0, %2"
                 : "=&v"(t0), "=&v"(t1), "=&v"(t2), "=&v"(t3),
                   "+v"(s[0][0]), "+v"(s[0][1]), "+v"(s[0][2]), "+v"(s[0][3]), "+v"(s[1][0]), "+v"(s[1][1]), "+v"(s[1][2]), "+v"(s[1][3]),
                   "+v"(s[2][0]), "+v"(s[2][1]), "+v"(s[2][2]), "+v"(s[2][3]), "+v"(s[3][0]), "+v"(s[3][1]), "+v"(s[3][2]), "+v"(s[3][3]));
    const float ps = t0;
    l += sel ? ps : 0.f;
    unsigned u0, u1, u2, u3; asm volatile("" : "=v"(u0), "=v"(u1), "=v"(u2), "=v"(u3));
    u0 = __builtin_amdgcn_cvt_pk_fp8_f32(s[0][0], s[0][1], u0, false); u0 = __builtin_amdgcn_cvt_pk_fp8_f32(s[0][2], s[0][3], u0, true);
    u1 = __builtin_amdgcn_cvt_pk_fp8_f32(s[1][0], s[1][1], u1, false); u1 = __builtin_amdgcn_cvt_pk_fp8_f32(s[1][2], s[1][3], u1, true);
    u2 = __builtin_amdgcn_cvt_pk_fp8_f32(s[2][0], s[2][1], u2, false); u2 = __builtin_amdgcn_cvt_pk_fp8_f32(s[2][2], s[2][3], u2, true);
    u3 = __builtin_amdgcn_cvt_pk_fp8_f32(s[3][0], s[3][1], u3, false); u3 = __builtin_amdgcn_cvt_pk_fp8_f32(s[3][2], s[3][3], u3, true);
    return (i32x4_t){sel ? (int)u0 : 0, sel ? (int)u1 : 0, sel ? (int)u2 : 0, sel ? (int)u3 : 0};
}
__device__ __forceinline__ i32x4_t sm_quarter(f32x4 (&s)[4], const bool sel, const bool mk, const int dq, const unsigned W, float& mC, f32x4& cv, float& l, f32x4 (&o)[8], i32x4_t& pprev) {
    constexpr float THR2 = THR * 1.4426950408889634f;
    if (mk) mask16(s, dq, W);
    float pm = max16(s); pm = sel ? pm : -__builtin_inff();
    if (__builtin_expect(!__all(pm <= THR2), 0)) {
        float rm = pm; rm = fmaxf(rm, __shfl_xor(rm, 16)); rm = fmaxf(rm, __shfl_xor(rm, 32));
        const float d = fmaxf(rm, 0.f), alpha = __builtin_amdgcn_exp2f(-d); mC += d; l *= alpha;
#pragma unroll
        for (int m = 0; m < 4; ++m) s[m] -= d;
        cv = (f32x4){-mC, -mC, -mC, -mC};
#pragma unroll
        for (int db = 0; db < 8; ++db) o[db] *= alpha;
#pragma unroll
        for (int m = 0; m < 4; ++m) { const int w = pprev[m];
            unsigned u = __builtin_amdgcn_cvt_pk_fp8_f32(__builtin_amdgcn_cvt_f32_fp8(w, 0) * alpha, __builtin_amdgcn_cvt_f32_fp8(w, 1) * alpha, 0u, false);
            u = __builtin_amdgcn_cvt_pk_fp8_f32(__builtin_amdgcn_cvt_f32_fp8(w, 2) * alpha, __builtin_amdgcn_cvt_f32_fp8(w, 3) * alpha, u, true); pprev[m] = (int)u; }
    }
    return exp_pack16(s, sel, l);
}

__device__ __forceinline__ void attn_unit(const AttnP& P, int b, int g, int i, LAS char* lds, int wid) {
    const int lane = lane_id_(), tid = wid * 64 + lane, r32 = lane & 31, hi = lane >> 5;
    LAS char* V_lds = lds + L_V; LAS char* K_lds = lds + L_K;
    LAS float* ws = (LAS float*)(lds + L_WS) + wid * 64; LAS float* li_l = ws; LAS float* al_l = ws + 32;
    LAS float* impA = (LAS float*)(lds + L_IMP); LAS float* impB = impA + 64 * 128;
    LAS unsigned* oacc = (LAS unsigned*)(lds + L_OACC) + wid * 2048 + lane;
    LAS unsigned* selw = (LAS unsigned*)(lds + L_SEL);
    const int q0 = i * 64, tokl = 8 * wid + (r32 >> 2), head = r32 & 3, tpos = q0 + tokl;
    const size_t tokrow = (size_t)b * SEQ + tpos;
    const int bg = b * NKV + g;
    const unsigned koff0 = (unsigned)((wid * 8 + (lane >> 4)) * 256 + (((lane & 15) ^ (lane >> 4)) << 4)), koff1 = (unsigned)((wid * 8 + 4 + (lane >> 4)) * 256 + (((lane & 15) ^ (4 + (lane >> 4))) << 4));
    unsigned voff0; { const int kk = wid * 8 + ((lane >> 2) & 7), k = (kk & ~0xC) | ((kk & 4) << 1) | ((kk & 8) >> 1); voff0 = (unsigned)(k * 256 + ((lane >> 5) * 32 + (lane & 3) * 8) * 2); }
    const int vb0 = (int)(uintptr_t)V_lds + v_rd_base(lane);
    bf16x8 qr[8];
    f32x16 p0, p1; f32x16 o[4]; float m_reg, l_reg, mn, alpha; bf16x8 pa0, pa1, pa2, pa3;
    constexpr float C2 = 1.4426950408889634f * SCALE;

#define DMA_K(Kp, k0, buf) do { const char* b_ = (const char*)(Kp) + (size_t)(k0) * (HD * 2); LAS unsigned* d_ = (LAS unsigned*)(K_lds + (buf) * SHM_K + wid * 2048); \
        unsigned o0_ = koff0, o1_ = koff1; asm volatile("" : "+v"(o0_), "+v"(o1_)); \
        __builtin_amdgcn_global_load_lds((const unsigned*)(b_ + o0_), d_, 16, 0, 0); __builtin_amdgcn_global_load_lds((const unsigned*)(b_ + o1_), d_ + 256, 16, 0, 0); } while (0)
#define DMA_V(Vp, k0, buf) do { const char* b_ = (const char*)(Vp) + (size_t)(k0) * (HD * 2); LAS unsigned* d_ = (LAS unsigned*)(V_lds + (buf) * SHM_V + wid * 2048); \
        unsigned o0_ = voff0; asm volatile("" : "+v"(o0_)); \
        __builtin_amdgcn_global_load_lds((const unsigned*)(b_ + o0_), d_, 16, 0, 0); __builtin_amdgcn_global_load_lds((const unsigned*)(b_ + o0_ + 128), d_ + 256, 16, 0, 0); } while (0)
#define ABAR() asm volatile("s_waitcnt lgkmcnt(0)\n\ts_barrier" ::: "memory")
#define VMW(n) asm volatile("s_waitcnt vmcnt(" #n ")" ::: "memory")
#define RESC(a) do { if (__any((a) < 1.f)) { if (hi == 0) al_l[r32] = (a); LDS_WAIT();              \
                     _Pragma("unroll") for (int d_ = 0; d_ < 4; ++d_) _Pragma("unroll") for (int r = 0; r < 16; ++r) o[d_][r] *= al_l[crow(r, hi)]; } } while (0)
#define LOADQ(Qp) do { _Pragma("unroll") for (int d0 = 0; d0 < 8; ++d0) qr[d0] = *(const bf16x8*)((Qp) + (tokrow * NH + g * 4 + head) * HD + d0 * 16 + hi * 8); } while (0)

    const bf16_t* Kc = P.KCMP + (size_t)bg * NCP * HD; const bf16_t* Vc = P.VCMP + (size_t)bg * NCP * HD;
    const int ncmp = 4 * i + 3, NTC = (ncmp + 63) >> 6;
    const int tc = tpos >= 31 ? ((tpos - 31) >> 4) : -1;
    LOADQ(P.QRAW);
    m_reg = -1e30f; l_reg = 0.f;
    DMA_K(Kc, 0, 0); VMW(0); ABAR();
    for (int t = 0; t < NTC; ++t) {
        if (t + 1 < NTC) DMA_K(Kc, (t + 1) * 64, (t + 1) & 1);
        qkt<0>(p0, p1, K_lds + (t & 1) * SHM_K, r32, hi, qr);
        if (__any(t * 64 + 63 > tc)) mask_tile(p0, p1, tc - t * 64 - 4 * hi, 0x7fffffffu);
        partialSM(p0, p1, m_reg, mn, alpha); finishStats(p0, p1, alpha, l_reg);
        VMW(0); ABAR();
    }
    const float mL = l_reg > 0.f ? -m_reg * C2 - __builtin_amdgcn_logf(l_reg) : -__builtin_inff();
#pragma unroll
    for (int d = 0; d < 4; ++d) o[d] = f32x16{};
    DMA_K(Kc, 0, 0); DMA_V(Vc, 0, 0); VMW(0); ABAR();
    for (int t = 0; t < NTC; ++t) {
        if (t + 1 < NTC) { DMA_K(Kc, (t + 1) * 64, (t + 1) & 1); DMA_V(Vc, (t + 1) * 64, (t + 1) & 1); }
        qkt<0>(p0, p1, K_lds + (t & 1) * SHM_K, r32, hi, qr);
        if (__any(t * 64 + 63 > tc)) mask_tile(p0, p1, tc - t * 64 - 4 * hi, 0x7fffffffu);
#pragma unroll
        for (int r = 0; r < 16; ++r) { p0[r] = __builtin_amdgcn_exp2f(fmaf(p0[r], C2, mL)); p1[r] = __builtin_amdgcn_exp2f(fmaf(p1[r], C2, mL)); }
        if (i >= 16) {
#pragma unroll
            for (int q = 0; q < 8; ++q) {
                const float x0 = q < 4 ? p0[4 * q] : p1[4 * (q - 4)], x1 = q < 4 ? p0[4 * q + 1] : p1[4 * (q - 4) + 1], x2 = q < 4 ? p0[4 * q + 2] : p1[4 * (q - 4) + 2], x3 = q < 4 ? p0[4 * q + 3] : p1[4 * (q - 4) + 3];
                float av = 2.f * ((x0 + x1) + x2) + x3, bv = x3;
                av += dppf<DPP_X1>(av); av += dppf<DPP_X2>(av); bv += dppf<DPP_X1>(bv); bv += dppf<DPP_X2>(bv);
                const int jb = 16 * t + 2 * (q & 3) + hi + 8 * (q >> 2);
                if (head == 0) { impA[tokl * 128 + jb] = av; impB[tokl * 128 + jb] = bv; } }
        }
        PK4(p0, 0, pa0); PK4(p0, 8, pa1); PK4(p1, 0, pa2); PK4(p1, 8, pa3);
        pv_tile<0>(o, vb0 + (t & 1) * SHM_V, pa0, pa1, pa2, pa3);
        VMW(0); ABAR();
    }
    {
        int tk = tid; asm volatile("" : "+v"(tk));
        const int tl = tk >> 3, sub = tk & 7; unsigned sel = 0u;
        if (i < 16) {
#pragma unroll
            for (int jj = 0; jj < 16; ++jj) if (sub * 16 + jj <= i) sel |= 1u << jj;
        } else {
            unsigned key[16];
            LAS const float* ia = impA + tl * 128 + sub * 16; LAS const float* ib = impB + tl * 128 + sub * 16 - 1;
            float va[16];
#pragma unroll
            for (int jj = 0; jj < 16; ++jj) va[jj] = ia[jj] + ib[jj];
#pragma unroll
            for (int jj = 0; jj < 16; ++jj) { const int j = sub * 16 + jj; const bool valid = (j >= 1) && (j <= i - 2);
                key[jj] = valid ? ((__float_as_uint(va[jj]) & 0xFFFFFF80u) | (unsigned)(127 - j)) : 0u; }
#define TK_CE(a_, b_) do { const unsigned hi_ = key[a_] > key[b_] ? key[a_] : key[b_], lo_ = key[a_] > key[b_] ? key[b_] : key[a_]; key[a_] = hi_; key[b_] = lo_; } while (0)
#pragma unroll
            for (int p = 1; p < 16; p *= 2)
#pragma unroll
                for (int k = p; k >= 1; k /= 2)
#pragma unroll
                    for (int j = k % p; j + k < 16; j += 2 * k)
#pragma unroll
                        for (int i2 = 0; i2 < k; ++i2) if (i2 + j + k < 16 && (i2 + j) / (2 * p) == (i2 + j + k) / (2 * p)) TK_CE(i2 + j, i2 + j + k);
#undef TK_CE
#pragma unroll 1
            for (int round = 0; round < 13; ++round) {
                unsigned gm = key[0]; { unsigned o1 = dppu<DPP_X1>(gm); gm = gm > o1 ? gm : o1; o1 = dppu<DPP_X2>(gm); gm = gm > o1 ? gm : o1; o1 = dppu<DPP_HM>(gm); gm = gm > o1 ? gm : o1; }
                const bool win = key[0] == gm && gm != 0u;
                sel |= win ? 1u << ((127u - (gm & 127u)) & 15u) : 0u;
#pragma unroll
                for (int q = 0; q < 15; ++q) key[q] = win ? key[q + 1] : key[q];
                key[15] = win ? 0u : key[15];
            }
#pragma unroll
            for (int jj = 0; jj < 16; ++jj) { const int j = sub * 16 + jj; if (j == 0 || j == i || j == i - 1) sel |= 1u << jj; }
        }
        __syncthreads();
        ((LAS unsigned short*)selw)[tl * 8 + sub] = (unsigned short)sel;
    }
    {
        if (hi == 0) li_l[r32] = P.G[tokrow * GLD + (g * 4 + head) * 3 + 0];
        LDS_WAIT(); SBAR();
        LAS char* img = lds + L_OACC + wid * 8192;
#pragma unroll
        for (int r = 0; r < 16; ++r) { const int row = crow(r, hi); const float gt = li_l[row]; LAS char* ir = img + row * 256;
#pragma unroll
            for (int d0 = 0; d0 < 4; ++d0) { const int d = d0 * 32 + r32;
                *(LAS unsigned short*)(ir + ((((d >> 2) ^ ((row & 15) << 1))) << 3) + ((d & 3) << 1)) = (unsigned short)cvtpk(o[d0][r] * gt, 0.f); } }
    }
    LDS_WAIT(); __syncthreads();

    {
    int l2 = lane_id_(); asm volatile("" : "+v"(l2));
    const int n = l2 & 15, kg = l2 >> 4;
    i32x8_t Qf[2]; int tposh[2]; constexpr float QSC = 8.f * 1.4426950408889634f * SCALE;
#pragma unroll
    for (int h = 0; h < 2; ++h) {
        tposh[h] = q0 + 8 * wid + 4 * h + (n >> 2);
        const float tp = (float)tposh[h], sgn = kg < 2 ? -1.f : 1.f;
        const bf16_t* qrow = P.QRAW + (((size_t)b * SEQ + tposh[h]) * NH + g * 4 + (n & 3)) * HD;
        const int dA = 32 * kg, dB = dA ^ 64;
#pragma unroll
        for (int c = 0; c < 4; ++c) { const u32x4 xa = *(const u32x4*)(qrow + dA + 8 * c), xb = *(const u32x4*)(qrow + dB + 8 * c); float rr[8];
#pragma unroll
            for (int jj = 0; jj < 8; ++jj) { const float a = (jj & 1) ? bfhi(xa[jj >> 1]) : bflo(xa[jj >> 1]), pb = (jj & 1) ? bfhi(xb[jj >> 1]) : bflo(xb[jj >> 1]);
                const float invr = exp2f(-(float)(32 * (kg & 1) + 8 * c + jj) * (13.287712379549449f / 64.f)) * 0.15915494309189535f;
                const float fr_ = __builtin_amdgcn_fractf(tp * invr); const float cc = __builtin_amdgcn_cosf(fr_), sn = __builtin_amdgcn_sinf(fr_);
                rr[jj] = (a * cc + sgn * (pb * sn)) * QSC; }
            const u32x2 w = pk8_fp8(rr); Qf[h][2 * c] = (int)w.x; Qf[h][2 * c + 1] = (int)w.y; } }
    unsigned kof0, kof1, vof0, vof1, kra0, kra1, vra0, vra1;
    { const int r0 = 16 * wid + (l2 >> 3), r1 = r0 + 8, sl = l2 & 7;
      kof0 = (unsigned)(r0 * 128 + ((sl ^ ((r0 >> 1) & 7)) << 4)); kof1 = (unsigned)(r1 * 128 + ((sl ^ ((r1 >> 1) & 7)) << 4));
      vof0 = (unsigned)(r0 * SEQ + ((sl ^ ((r0 >> 1) & 7)) << 4)); vof1 = (unsigned)(r1 * SEQ + ((sl ^ ((r1 >> 1) & 7)) << 4));
      const int sw = (n >> 1) & 7;
      kra0 = (unsigned)(uintptr_t)K_lds + (unsigned)(n * 128 + (((2 * kg) ^ sw) << 4)); kra1 = (unsigned)(uintptr_t)K_lds + (unsigned)(n * 128 + (((2 * kg + 1) ^ sw) << 4));
      vra0 = (unsigned)(uintptr_t)V_lds + (unsigned)(n * 128 + ((kg ^ sw) << 4)); vra1 = (unsigned)(uintptr_t)V_lds + (unsigned)(n * 128 + (((4 + kg) ^ sw) << 4)); }
#pragma unroll 1
    for (int br = 1; br <= 2; ++br) {
        const unsigned char* Kp = (br == 1 ? P.KS8 : P.KW8) + (size_t)bg * SEQ * HD; const unsigned char* Vp = (br == 1 ? P.VTS : P.VTW) + (size_t)bg * HD * SEQ;
        const int jlo = br == 1 ? 0 : (i > 8 ? i - 8 : 0), NS = (i - jlo + 2) >> 1;
        const unsigned W = br == 1 ? 0x7fffffffu : 512u;
        unsigned sw00 = 0, sw01 = 0, sw02 = 0, sw03 = 0, sw10 = 0, sw11 = 0, sw12 = 0, sw13 = 0;
        if (br == 1) { const int t0 = (8 * wid + (n >> 2)) * 4, t1 = t0 + 16;
            sw00 = selw[t0]; sw01 = selw[t0 + 1]; sw02 = selw[t0 + 2]; sw03 = selw[t0 + 3]; sw10 = selw[t1]; sw11 = selw[t1 + 1]; sw12 = selw[t1 + 2]; sw13 = selw[t1 + 3]; }
#define SELW0(j_) ((((j_) & 64) ? (((j_) & 32) ? sw03 : sw02) : (((j_) & 32) ? sw01 : sw00)) >> ((j_) & 31))
#define SELW1(j_) ((((j_) & 64) ? (((j_) & 32) ? sw13 : sw12) : (((j_) & 32) ? sw11 : sw10)) >> ((j_) & 31))
        f32x4 o0[8], o1[8];
#pragma unroll
        for (int db = 0; db < 8; ++db) { o0[db] = (f32x4){0.f, 0.f, 0.f, 0.f}; o1[db] = (f32x4){0.f, 0.f, 0.f, 0.f}; }
        float mC0 = 0.f, mC1 = 0.f, l0 = 0.f, l1 = 0.f;
        f32x4 cv[2] = {(f32x4){0.f, 0.f, 0.f, 0.f}, (f32x4){0.f, 0.f, 0.f, 0.f}};
        i32x4_t pl0 = {0, 0, 0, 0}, ph0 = {0, 0, 0, 0}, pl1 = {0, 0, 0, 0}, ph1 = {0, 0, 0, 0};
        f32x4 sa0[4], sa1[4];
        bool pa0 = false, pa1 = false;
#define DMA_K16(J_) do { const unsigned char* b_ = Kp + (size_t)(jlo + 2 * (J_)) * 64 * HD; LAS unsigned* d_ = (LAS unsigned*)(K_lds + ((J_) & 1) * 16384 + wid * 2048); \
            unsigned o0_ = kof0, o1_ = kof1; asm volatile("" : "+v"(o0_), "+v"(o1_)); \
            __builtin_amdgcn_global_load_lds((const unsigned*)(b_ + o0_), d_, 16, 0, 0); __builtin_amdgcn_global_load_lds((const unsigned*)(b_ + o1_), d_ + 256, 16, 0, 0); } while (0)
#define DMA_V16(J_) do { const unsigned char* b_ = Vp + (size_t)(jlo + 2 * (J_)) * 64; LAS unsigned* d_ = (LAS unsigned*)(V_lds + ((J_) & 1) * 16384 + wid * 2048); \
            unsigned o0_ = vof0, o1_ = vof1; asm volatile("" : "+v"(o0_), "+v"(o1_)); \
            __builtin_amdgcn_global_load_lds((const unsigned*)(b_ + o0_), d_, 16, 0, 0); __builtin_amdgcn_global_load_lds((const unsigned*)(b_ + o1_), d_ + 256, 16, 0, 0); } while (0)
        DMA_K16(0); VMW(0); ABAR();
        if (wid < 4) __builtin_amdgcn_s_setprio(1);
#pragma unroll 1
        for (int J = 0; J <= NS; ++J) {
            if (J < NS) DMA_V16(J);
            if (J + 1 < NS) DMA_K16(J + 1);
            if (J >= 1 && (pa0 || pa1)) { const unsigned vs_ = (unsigned)(((J - 1) & 1) * 16384); const i32x8_t P8[2] = {cat88(pl0, ph0), cat88(pl1, ph1)};
                pv_step<3>(o0, o1, vra0 + vs_, vra1 + vs_, P8);
                }
            pa0 = false; pa1 = false;
            if (J < NS) {
#pragma unroll
                for (int c = 0; c < 2; ++c) {
                    const int jc = jlo + 2 * J + c;
                    bool s0, s1;
                    if (br == 1) { s0 = SELW0(jc) & 1u; s1 = SELW1(jc) & 1u; } else { s0 = jc <= i; s1 = s0; }
                    const bool a0 = __any(s0), a1 = __any(s1);
                    const unsigned ks_ = (unsigned)((J & 1) * 16384 + c * 8192);
                        if (a0 && a1) qk_half<3>(sa0, sa1, kra0 + ks_, kra1 + ks_, Qf, cv); else if (a0) qk_half<1>(sa0, sa1, kra0 + ks_, kra1 + ks_, Qf, cv); else if (a1) qk_half<2>(sa0, sa1, kra0 + ks_, kra1 + ks_, Qf, cv);
                    const bool mk = (jc == i) || (br == 2 && jc + 8 == i);
                    i32x4_t q0_ = {0, 0, 0, 0}, q1_ = {0, 0, 0, 0};
                    if (a0) q0_ = sm_quarter(sa0, s0, mk, tposh[0] - jc * 64 - 4 * kg, W, mC0, cv[0], l0, o0, pl0);
                    if (a1) q1_ = sm_quarter(sa1, s1, mk, tposh[1] - jc * 64 - 4 * kg, W, mC1, cv[1], l1, o1, pl1);
                    if (c == 0) { pl0 = q0_; pl1 = q1_; } else { ph0 = q0_; ph1 = q1_; }
                    pa0 = pa0 || a0; pa1 = pa1 || a1;
                }
            }
            VMW(0); ABAR();
        }
        __builtin_amdgcn_s_setprio(0);
#undef DMA_K16
#undef DMA_V16
#undef SELW0
#undef SELW1
        const int l3 = lane_id_(), n = l3 & 15, kg = l3 >> 4; const int tposh[2] = {q0 + 8 * wid + (n >> 2), q0 + 8 * wid + 4 + (n >> 2)};
        LAS char* img = lds + L_OACC + wid * 8192;
        l0 += __shfl_xor(l0, 16); l0 += __shfl_xor(l0, 32); l1 += __shfl_xor(l1, 16); l1 += __shfl_xor(l1, 32);
        float gs[2];
        { const float g0_ = P.G[((size_t)b * SEQ + tposh[0]) * GLD + (g * 4 + (n & 3)) * 3 + br], g1_ = P.G[((size_t)b * SEQ + tposh[1]) * GLD + (g * 4 + (n & 3)) * 3 + br];
          gs[0] = l0 > 0.f ? g0_ / l0 : 0.f; gs[1] = l1 > 0.f ? g1_ / l1 : 0.f; }
        if (br == 1) {
#pragma unroll
            for (int h = 0; h < 2; ++h)
#pragma unroll
                for (int db = 0; db < 8; ++db) { LAS u32x2* ip = (LAS u32x2*)(img + (16 * h + n) * 256 + (((4 * db + kg) ^ (2 * n)) << 3)); const u32x2 w = *ip; const f32x4 ov = (h ? o1[db] : o0[db]) * gs[h];
                    *ip = (u32x2){cvtpk(bflo(w.x) + ov[0], bfhi(w.x) + ov[1]), cvtpk(bflo(w.y) + ov[2], bfhi(w.y) + ov[3])}; }
            LDS_WAIT();
        } else {
#pragma unroll
            for (int h = 0; h < 2; ++h) { float sq = 0.f;
                unsigned char* orow = (unsigned char*)P.MIXED + ((size_t)b * SEQ + tposh[h]) * DM + CCH + (g * 4 + (n & 3)) * HD + 4 * kg;
#pragma unroll
                for (int db = 0; db < 8; ++db) { const u32x2 w = *(LAS const u32x2*)(img + (16 * h + n) * 256 + (((4 * db + kg) ^ (2 * n)) << 3)); const f32x4 ov = (h ? o1[db] : o0[db]) * gs[h];
                    const float v0 = bflo(w.x) + ov[0], v1 = bfhi(w.x) + ov[1], v2 = bflo(w.y) + ov[2], v3 = bfhi(w.y) + ov[3];
                    sq += (v0 * v0 + v1 * v1) + (v2 * v2 + v3 * v3);
                    if constexpr (OUT_FP8) { unsigned w8 = __builtin_amdgcn_cvt_pk_fp8_f32(clamp448(v0 * A8N), clamp448(v1 * A8N), 0u, false); w8 = __builtin_amdgcn_cvt_pk_fp8_f32(clamp448(v2 * A8N), clamp448(v3 * A8N), w8, true);
                        *(unsigned*)(orow + 16 * db) = w8; }
                    else { *(u32x2*)((bf16_t*)P.MIXED + ((size_t)b * SEQ + tposh[h]) * DM + CCH + (g * 4 + (n & 3)) * HD + 16 * db + 4 * kg) = (u32x2){cvtpk(v0, v1), cvtpk(v2, v3)}; } }
                sq += dppf<DPP_X1>(sq); sq += dppf<DPP_X2>(sq); sq += __shfl_xor(sq, 16); sq += __shfl_xor(sq, 32);
                if ((n & 3) == 0 && kg == 0) atomicAdd(P.ssn + (size_t)b * SEQ + tposh[h], fixu(sq, SSN)); }
        }
    }
    }
    __syncthreads();
#undef DMA_K
#undef DMA_V
#undef ABAR
#undef VMW
#undef RESC
#undef LOADQ
}
#undef PK4
#undef KSWZ
}

#define XB_TMO      128
#define XB_XCNT(j)  (256  + 64 * (j))
#define XB_XSUB(j)  (1280 + 64 * (j))
#define XB_XGEN(j)  (2304 + 64 * (j))
#define XB_TOP      3328
#define XB_TOPGEN   3392
#define XCD_BAR_WORDS 3456
#define XB_SPIN_CAP (1u << 20)
__device__ __forceinline__ unsigned xb_ld(unsigned* p)              { return __hip_atomic_load(p, __ATOMIC_RELAXED, __HIP_MEMORY_SCOPE_AGENT); }
__device__ __forceinline__ unsigned xb_add(unsigned* p, unsigned v) { return __hip_atomic_fetch_add(p, v, __ATOMIC_RELAXED, __HIP_MEMORY_SCOPE_AGENT); }
__device__ __forceinline__ unsigned xb_xcc_id() { return (unsigned)__builtin_amdgcn_s_getreg((3 << 11) | 20) & 0xFu; }
#define XB_SPIN(cond, bar) do { unsigned _sp = 0; while (cond) { __builtin_amdgcn_s_sleep(1); \
    if ((++_sp & 255u) == 0u) { if (xb_ld(&(bar)[XB_TMO])) break; if (_sp > XB_SPIN_CAP) { atomicAdd(&(bar)[XB_TMO], 1u); break; } } } } while (0)
struct XcdBarrier { unsigned* bar; unsigned x; volatile LAS unsigned* st; int wave; };
__device__ __forceinline__ XcdBarrier xcd_barrier_post(unsigned* bar, volatile LAS unsigned* st, int wave) {
    XcdBarrier b; b.bar = bar; b.x = xb_xcc_id(); b.st = st; b.wave = wave;
    if (wave == 0 && lane_id_() == 0) (void)xb_add(&bar[XB_XCNT(b.x)], 1u);
    return b;
}
__device__ __forceinline__ void xcd_barrier_complete(unsigned* bar, unsigned x, unsigned& nloc, unsigned& nx) {
    const unsigned G = gridDim.x * gridDim.y * gridDim.z;
    unsigned sum, cnt, mine, sp = 0u;
    for (;;) {
        sum = 0u; cnt = 0u; mine = 0u;
#pragma unroll
        for (unsigned j = 0; j < 16; ++j) { const unsigned c = xb_ld(&bar[XB_XCNT(j)]); sum += c; cnt += (c > 0u) ? 1u : 0u; mine = (j == x) ? c : mine; }
        if (sum == G) break;
        __builtin_amdgcn_s_sleep(1);
        if ((++sp & 255u) == 0u) { if (xb_ld(&bar[XB_TMO])) break; if (sp > XB_SPIN_CAP) { atomicAdd(&bar[XB_TMO], 1u); break; } }
    }
    nloc = mine > 0u ? mine : 1u; nx = cnt > 0u ? cnt : 1u;
}
__device__ __forceinline__ void xcd_barrier(const XcdBarrier& b) {
    asm volatile("s_waitcnt vmcnt(0)" ::: "memory");
    __syncthreads();
    if (b.wave == 0 && lane_id_() == 0) {
        unsigned* bar = b.bar;
        __builtin_amdgcn_s_waitcnt(0);
        unsigned nloc = b.st[0], nx = b.st[1];
        if (nloc == 0u) { xcd_barrier_complete(bar, b.x, nloc, nx); b.st[0] = nloc; b.st[1] = nx; }
        const unsigned old = xb_add(&bar[XB_XSUB(b.x)], 1u);
        const unsigned gen = old / nloc;
        if (old + 1u == (gen + 1u) * nloc) {
            __builtin_amdgcn_fence(__ATOMIC_RELEASE, "agent");
            asm volatile("s_waitcnt vmcnt(0)" ::: "memory");
            const unsigned og = xb_add(&bar[XB_TOP], 1u);
            const unsigned tg = og / nx;
            if (og + 1u == (tg + 1u) * nx) xb_add(&bar[XB_TOPGEN], 1u);
            else XB_SPIN(xb_ld(&bar[XB_TOPGEN]) == tg, bar);
            __builtin_amdgcn_fence(__ATOMIC_ACQUIRE, "agent");
            xb_add(&bar[XB_XGEN(b.x)], 1u);
            asm volatile("s_waitcnt vmcnt(0)" ::: "memory");
        } else {
            XB_SPIN(xb_ld(&bar[XB_XGEN(b.x)]) == gen, bar);
            __builtin_amdgcn_fence(__ATOMIC_ACQUIRE, "agent");
            asm volatile("s_waitcnt vmcnt(0)" ::: "memory");
        }
    }
    __syncthreads();
}

__device__ __forceinline__ int win_row(int n) {
    if (n < 512) return 256 * (15 + (n >> 7)) + (n & 127);
    if (n < 1024) { const int j = n - 512; return 256 * (15 + (j >> 7)) + 128 + (j & 127); }
    if (n < 2560) { const int j = n - 1024, h = j >> 7, e = j & 127; return 256 * (h >> 1) + 128 * (e >> 6) + 64 * (h & 1) + (e & 63); }
    if (n < 4864) { const int j = n - 2560, blk = j / 384, r = j % 384, h = r >> 7, e = r & 127;
        if (blk == 2 || blk == 4) { const int rh = (blk == 2 ? 0 : 3) + h; return 256 * (6 + (rh >> 1)) + 128 * (e >> 6) + 64 * (rh & 1) + (e & 63); }
        const int ph = (blk == 0 ? 0 : (blk == 1 ? 3 : (blk == 3 ? 6 : 9))) + h; return 256 * (9 + (ph >> 1)) + 128 * (ph & 1) + e; }
    return 256 * 19 + (n - 4864);
}
__device__ __forceinline__ int dest_row(int kind, int n) {
    if (kind == 0) return n;
    if (kind == 1) return ((n >> 7) << 8) + (n & 127);
    if (kind == 2) return ((n >> 7) << 8) + 128 + (n & 127);
    return win_row(n);
}
template <int QM = 0>
__device__ __forceinline__ void transpose_item(const float* W, int K, int N, void* WTv, int kind, const float* gk, float s, int item, int lane, int KP = 0) {
    constexpr bool F8 = QM != 0; constexpr int KI = F8 ? 128 : 64, KL = KI / 8;
    const int nblk = (N + 31) / 32, kb = item / nblk, nb = item % nblk, k0 = KI * kb + KL * (lane >> 3), n0 = 32 * nb + 4 * (lane & 7);
    if (n0 >= N) return;
    f32x4 v[KL];
    const float* src = W + (size_t)k0 * N + n0;
#pragma unroll
    for (int i = 0; i < KL; ++i) v[i] = *(const f32x4*)(src + (size_t)i * N);
    if (gk) {
#pragma unroll
        for (int i = 0; i < KL; i += 4) { const f32x4 g = *(const f32x4*)(gk + k0 + i); v[i] *= g.x; v[i + 1] *= g.y; v[i + 2] *= g.z; v[i + 3] *= g.w; } }
#pragma unroll
    for (int j = 0; j < 4; ++j) { const int dr = dest_row(kind, n0 + j);
        if constexpr (F8) { float a[8], b[8];
#pragma unroll
            for (int i = 0; i < 8; ++i) { a[i] = v[i][j] * s; b[i] = v[8 + i][j] * s; }
            const u32x2 lo = QM == 2 ? pk8_i8(a, 1.f) : pk8_fp8(a), hi = QM == 2 ? pk8_i8(b, 1.f) : pk8_fp8(b);
            *(u32x4*)((unsigned char*)WTv + (size_t)dr * KP + k0) = (u32x4){lo.x, lo.y, hi.x, hi.y}; }
        else { u32x4 o; o.x = cvtpk(v[0][j] * s, v[1][j] * s); o.y = cvtpk(v[2][j] * s, v[3][j] * s); o.z = cvtpk(v[4][j] * s, v[5][j] * s); o.w = cvtpk(v[6][j] * s, v[7][j] * s);
            *(u32x4*)((bf16_t*)WTv + (size_t)dr * K + k0) = o; } }
}

#define CAS __attribute__((address_space(4)))
typedef const float* const CAS* InTab;
struct Frame {
    LAS unsigned char* lds; int wave, vcu, G;
    InTab in; float* out; unsigned char* ws;
};
#define FRESH_IN(F) do { InTab t_ = (F).in; asm volatile("" : "+s"(t_)); (F).in = t_; } while (0)

__device__ __forceinline__ void p0_prologue(Frame& F) {
    const int LN = lane_id_();
    const int gw = F.vcu * NWAVES + F.wave, NGW = F.G * NWAVES;
    unsigned char* ws = F.ws;
    constexpr int I_F = (DM / 128) * (FF / 32), I_D = (FF / 128) * (DM / 32), I_IN = (DM / 128) * ((NIN + 31) / 32), I_O = (DM / (OUT_FP8 ? 128 : 64)) * (DM / 32), I_C = (4096 / 64) * (256 / 32), I_P = (CCH / 64) * (CCH / 32);
    constexpr int NITEMS = 4 * I_F + 2 * I_D + I_IN + I_O + 2 * I_C + I_P;
    for (int it = gw; it < NITEMS; it += NGW) {
        int r = it;
        if (r < I_F) { transpose_item<2>(F.in[2], DM, FF, ws + WS_WGU1, 1, F.in[1], SW8, r, LN, DM); continue; } r -= I_F;
        if (r < I_F) { transpose_item<2>(F.in[3], DM, FF, ws + WS_WGU1, 2, F.in[1], SW8, r, LN, DM); continue; } r -= I_F;
        if (r < I_F) { transpose_item<2>(F.in[22], DM, FF, ws + WS_WGU2, 1, F.in[21], SW8, r, LN, DM); continue; } r -= I_F;
        if (r < I_F) { transpose_item<2>(F.in[23], DM, FF, ws + WS_WGU2, 2, F.in[21], SW8, r, LN, DM); continue; } r -= I_F;
        if (r < I_D) { transpose_item<1>(F.in[4], FF, DM, ws + WS_WD1, 0, nullptr, 0.5f * W8S, r, LN, FFP); continue; } r -= I_D;
        if (r < I_D) { transpose_item<1>(F.in[24], FF, DM, ws + WS_WD2, 0, nullptr, 0.5f * W8S, r, LN, FFP); continue; } r -= I_D;
        if (r < I_IN) { transpose_item<2>(F.in[6], DM, NIN, ws + WS_WIN, 3, F.in[5], SW8, r, LN, DM); continue; } r -= I_IN;
        if (r < I_O) { const int kb = r / (DM / 32);
            if (OUT_FP8) transpose_item<1>(F.in[20], DM, DM, ws + WS_WOUT, 0, kb < 4 ? F.in[18] : F.in[19] - CCH, W8S, r, LN, DM);
            else transpose_item(F.in[20], DM, DM, ws + WS_WOUT, 0, kb < 8 ? F.in[18] : F.in[19] - CCH, 1.f, r, LN); continue; } r -= I_O;
        if (r < I_C) { transpose_item(F.in[9], 4096, 256, ws + WS_WC1, 0, nullptr, 1.f, r, LN); continue; } r -= I_C;
        if (r < I_C) { transpose_item(F.in[11], 4096, 256, (bf16_t*)(ws + WS_WC1) + 256 * 4096, 0, nullptr, 1.f, r, LN); continue; } r -= I_C;
        transpose_item(F.in[17], CCH, CCH, ws + WS_WPW, 0, nullptr, 1.f, r, LN);
    }
    for (int rr = gw; rr < 220; rr += NGW) { u32x4* p = (u32x4*)(ws + WS_WIN + (size_t)(256 * 19 + 36 + rr) * DM);
#pragma unroll
        for (int j = 0; j < 2; ++j) p[LN + 64 * j] = (u32x4){0u, 0u, 0u, 0u}; }
    for (int rr = gw; rr < 2 * 256; rr += NGW) { u32x4* p = (u32x4*)(ws + (rr < 256 ? WS_WGU1 : WS_WGU2) + (size_t)(43 * 256 + (rr & 255)) * DM);
#pragma unroll
        for (int j = 0; j < 2; ++j) p[LN + 64 * j] = (u32x4){0u, 0u, 0u, 0u}; }
    for (int rr = gw; rr < 2 * DM / 8; rr += NGW) { const int which = rr / (DM / 8), r8 = (rr % (DM / 8)) * 8 + (LN >> 3);
        *(u32x4*)(ws + (which ? WS_WD2 : WS_WD1) + (size_t)r8 * FFP + FF + (LN & 7) * 16) = (u32x4){0u, 0u, 0u, 0u}; }
    { const float* x = F.in[0]; unsigned char* XB8 = ws + WS_XB8; unsigned* ss0 = (unsigned*)(ws + WS_SS0); float* rowf = (float*)(ws + WS_ROWF);
      for (int m = gw; m < T; m += NGW) { const f32x4* xr = (const f32x4*)(x + (size_t)m * DM) + 2 * LN; u32x2* o8 = (u32x2*)(XB8 + (size_t)m * DM) + LN; float s = 0.f, am = 0.f;
          f32x4 v[4], w[4];
#pragma unroll
          for (int j = 0; j < 4; ++j) { v[j] = xr[128 * j]; w[j] = xr[128 * j + 1]; }
#pragma unroll
          for (int j = 0; j < 4; ++j) { s += (v[j].x * v[j].x + v[j].y * v[j].y) + (v[j].z * v[j].z + v[j].w * v[j].w) + (w[j].x * w[j].x + w[j].y * w[j].y) + (w[j].z * w[j].z + w[j].w * w[j].w);
              am = fmaxf(fmaxf(fmaxf(am, fmaxf(fabsf(v[j].x), fabsf(v[j].y))), fmaxf(fabsf(v[j].z), fabsf(v[j].w))), fmaxf(fmaxf(fabsf(w[j].x), fabsf(w[j].y)), fmaxf(fabsf(w[j].z), fabsf(w[j].w)))); }
#pragma unroll
          for (int o = 1; o < 64; o <<= 1) am = fmaxf(am, __shfl_xor(am, o));
          am = fmaxf(am, 1e-20f); const float qs = 127.f / am;
#pragma unroll
          for (int j = 0; j < 4; ++j) { const float v8[8] = {v[j].x, v[j].y, v[j].z, v[j].w, w[j].x, w[j].y, w[j].z, w[j].w}; o8[64 * j] = pk8_i8(v8, qs); }
          s = wave_sum(s); if (LN == 0) { ss0[m] = fixu(s, SSX); rowf[m] = am * (1.f / 127.f); } } }
    { float* b1p = (float*)(ws + WS_B1) + 1024;
      for (int o = gw; o < 32; o += NGW) { const int kv = o >> 4, ch = o & 15; const float* pos = F.in[kv ? 8 : 7] + ch * 256; const float* w1 = F.in[kv ? 11 : 9] + (size_t)ch * 256 * 256 + LN * 4;
          f32x4 a = {0.f, 0.f, 0.f, 0.f};
#pragma unroll 8
          for (int k = 0; k < 256; ++k) a += *(const f32x4*)(w1 + (size_t)k * 256) * pos[k];
          *(f32x4*)(b1p + o * 256 + LN * 4) = a; } }
}

__device__ __forceinline__ void conv_phase(Frame& F) {
    const int LN = lane_id_(); const int TID = F.wave * 64 + LN;
    const bf16_t* U = (const bf16_t*)(F.ws + WS_U); bf16_t* S1 = (bf16_t*)(F.ws + WS_S1);
    const float* dw = F.in[13]; const int c = TID;
    float w[31];
#pragma unroll
    for (int k = 0; k < 31; ++k) w[k] = dw[k * CCH + c];
    const float bias = F.in[14][c];
    LAS float* ybuf = (LAS float*)F.lds;
    f32x4 lg0, lg1, lb0, lb1;
    { const float* g = F.in[15] + LN * 8; const float* bb = F.in[16] + LN * 8; lg0 = *(const f32x4*)g; lg1 = *(const f32x4*)(g + 4); lb0 = *(const f32x4*)bb; lb1 = *(const f32x4*)(bb + 4); }
    unsigned short ub[62];
#define CONV_LOAD(tile_) do { const int t0_ = (tile_) * 32, s0_ = t0_ & (SEQ - 1); _Pragma("unroll") for (int j = 0; j < 62; ++j) { const int pos = s0_ - 30 + j; ub[j] = pos >= 0 ? U[(size_t)(t0_ - 30 + j) * CCH + c] : (unsigned short)0; } } while (0)
    if (F.vcu < T / 32) CONV_LOAD(F.vcu);
    for (int tile = F.vcu; tile < T / 32; tile += F.G) {
        const int t0 = tile * 32;
        float u[62];
#pragma unroll
        for (int j = 0; j < 62; ++j) u[j] = bf2f(ub[j]);
#pragma unroll
        for (int tt = 0; tt < 32; ++tt) { float y = bias;
#pragma unroll
            for (int k = 0; k < 31; ++k) y = fmaf(w[k], u[tt + k], y);
            ybuf[tt * CCH + c] = y; }
        if (tile + F.G < T / 32) CONV_LOAD(tile + F.G);
        asm volatile("s_waitcnt lgkmcnt(0)\n\ts_barrier" ::: "memory");
#pragma unroll
        for (int q = 0; q < 4; ++q) { const int tt = F.wave * 4 + q; const LAS float* yr = ybuf + tt * CCH + LN * 8;
            const f32x4 y0 = *(const LAS f32x4*)yr, y1 = *(const LAS f32x4*)(yr + 4);
            float s = (y0.x + y0.y) + (y0.z + y0.w) + (y1.x + y1.y) + (y1.z + y1.w);
            const float mu = wave_sum(s) * (1.f / CCH);
            const f32x4 d0 = y0 - mu, d1 = y1 - mu;
            float s2 = (d0.x * d0.x + d0.y * d0.y) + (d0.z * d0.z + d0.w * d0.w) + (d1.x * d1.x + d1.y * d1.y) + (d1.z * d1.z + d1.w * d1.w);
            const float rstd = 1.0f / sqrtf(wave_sum(s2) * (1.f / CCH) + EPS);
            const f32x4 z0 = d0 * rstd * lg0 + lb0, z1 = d1 * rstd * lg1 + lb1;
            u32x4 o; o.x = cvtpk(siluf_(z0.x), siluf_(z0.y)); o.y = cvtpk(siluf_(z0.z), siluf_(z0.w)); o.z = cvtpk(siluf_(z1.x), siluf_(z1.y)); o.w = cvtpk(siluf_(z1.z), siluf_(z1.w));
            *(u32x4*)(S1 + (size_t)(t0 + tt) * CCH + LN * 8) = o; }
        asm volatile("s_waitcnt lgkmcnt(0)\n\ts_barrier" ::: "memory");
    }
#undef CONV_LOAD
}

__device__ __forceinline__ void vt8_phase(Frame& F) {
    const int LN = lane_id_(); const int TID = F.wave * 64 + LN; const int kq = TID >> 4, dc = TID & 15;
    const int blk = kq >> 4, kq6 = kq & 15, key0 = 64 * blk + 16 * (kq6 >> 2) + 4 * (kq6 & 3);
    const int col = 64 * blk + 16 * (kq6 & 3) + 4 * (kq6 >> 2);
    LAS unsigned char* img = (LAS unsigned char*)F.lds;
    for (int id = F.vcu; id < 2 * 12 * (SEQ / 128); id += F.G) { const int tn = id / (12 * (SEQ / 128)), r = id % (12 * (SEQ / 128)), bg = r / (SEQ / 128), j = r % (SEQ / 128);
        const bf16_t* src = (const bf16_t*)(F.ws + (tn ? WS_VW : WS_VS)) + ((size_t)bg * SEQ + 128 * j + key0) * HD + 8 * dc;
        u32x4 x[4];
#pragma unroll
        for (int e = 0; e < 4; ++e) x[e] = *(const u32x4*)(src + (size_t)e * HD);
#pragma unroll
        for (int i = 0; i < 8; ++i) { float v[4];
#pragma unroll
            for (int e = 0; e < 4; ++e) v[e] = (i & 1) ? bfhi(x[e][i >> 1]) : bflo(x[e][i >> 1]);
            unsigned w = __builtin_amdgcn_cvt_pk_fp8_f32(clamp448(v[0]), clamp448(v[1]), 0u, false); w = __builtin_amdgcn_cvt_pk_fp8_f32(clamp448(v[2]), clamp448(v[3]), w, true);
            const int d = 8 * dc + i;
            *(LAS unsigned*)(img + d * 128 + ((((col >> 4) ^ ((d >> 3) & 7))) << 4) + (col & 12)) = w; }
        asm volatile("s_waitcnt lgkmcnt(0)\n\ts_barrier" ::: "memory");
        unsigned char* dst = F.ws + (tn ? WS_VTW : WS_VTS) + (size_t)bg * HD * SEQ + 128 * j;
#pragma unroll
        for (int q = 0; q < 2; ++q) { const int cj = TID + 512 * q, d = cj >> 3, s = cj & 7;
            *(u32x4*)(dst + (size_t)d * SEQ + ((s ^ ((d >> 3) & 7)) << 4)) = *(LAS const u32x4*)(img + d * 128 + (s << 4)); }
        asm volatile("s_waitcnt lgkmcnt(0)\n\ts_barrier" ::: "memory");
    }
}

__device__ __forceinline__ void cmp2_phase(Frame& F) {
    const int LN = lane_id_();
    const float* Pp = (const float*)(F.ws + WS_CMPP); const float* b1 = (const float*)(F.ws + WS_B1);
    constexpr int RW = 6;
    LAS float* hb = (LAS float*)F.lds + F.wave * (RW * 256);
    for (int grp = F.vcu; grp < (2 * 12 * NCP) / (8 * RW); grp += F.G) {
        const int row0 = (grp * 8 + F.wave) * RW, kv = row0 / (12 * NCP);
#pragma unroll
        for (int r = 0; r < RW; ++r) { const int m = (row0 + r) % (12 * NCP);
            f32x4 h = *(const f32x4*)(b1 + kv * 256 + LN * 4);
#pragma unroll
            for (int ks = 0; ks < 4; ++ks) h += *(const f32x4*)(Pp + ((size_t)(kv * 4 + ks) * (12 * NCP) + m) * 256 + LN * 4);
            h.x = siluf_(h.x); h.y = siluf_(h.y); h.z = siluf_(h.z); h.w = siluf_(h.w);
            *(LAS f32x4*)(hb + r * 256 + LN * 4) = h; }
        LDS_WAIT();
        const float* w2g = F.in[kv ? 12 : 10]; float a0[RW], a1[RW];
        LAS float* wl = (LAS float*)F.lds + 8 * RW * 256;
#pragma unroll
        for (int r = 0; r < RW; ++r) { a0[r] = 0.f; a1[r] = 0.f; }
#pragma unroll 1
        for (int half = 0; half < 2; ++half) {
            asm volatile("s_waitcnt lgkmcnt(0)\n\ts_barrier" ::: "memory");
#pragma unroll
            for (int pc = 0; pc < 8; ++pc) { const int piece = F.wave * 8 + pc;
                __builtin_amdgcn_global_load_lds((const unsigned*)(w2g + half * 16384 + piece * 256 + LN * 4), (LAS unsigned*)(wl + piece * 256), 16, 0, 0); }
            asm volatile("s_waitcnt vmcnt(0)\n\ts_barrier" ::: "memory");
#pragma unroll 2
            for (int k = 0; k < 128; k += 4) {
                const f32x2 w0 = *(const LAS f32x2*)(wl + (k + 0) * HD + LN * 2), w1 = *(const LAS f32x2*)(wl + (k + 1) * HD + LN * 2), w2v = *(const LAS f32x2*)(wl + (k + 2) * HD + LN * 2), w3 = *(const LAS f32x2*)(wl + (k + 3) * HD + LN * 2);
#pragma unroll
                for (int r = 0; r < RW; ++r) { const f32x4 hv = *(const LAS f32x4*)(hb + r * 256 + half * 128 + k);
                    a0[r] = fmaf(hv.x, w0.x, a0[r]); a1[r] = fmaf(hv.x, w0.y, a1[r]); a0[r] = fmaf(hv.y, w1.x, a0[r]); a1[r] = fmaf(hv.y, w1.y, a1[r]);
                    a0[r] = fmaf(hv.z, w2v.x, a0[r]); a1[r] = fmaf(hv.z, w2v.y, a1[r]); a0[r] = fmaf(hv.w, w3.x, a0[r]); a1[r] = fmaf(hv.w, w3.y, a1[r]); } }
        }
        bf16_t* dst = (bf16_t*)(F.ws + (kv ? WS_VCMP : WS_KCMP));
#pragma unroll
        for (int r = 0; r < RW; ++r) { const int m = (row0 + r) % (12 * NCP); const bool last = (m & (NCP - 1)) == NCP - 1;
            *(unsigned*)(dst + (size_t)m * HD + LN * 2) = last ? 0u : cvtpk(a0[r], a1[r]); }
        LDS_WAIT();
    }
}

__device__ __forceinline__ void final_phase(Frame& F) {
    const int LN = lane_id_();
    const unsigned* ss3 = (const unsigned*)(F.ws + WS_SS3); const float* gf = F.in[25]; const bf16_t* XB = (const bf16_t*)(F.ws + WS_XB);
    const int gw = F.vcu * NWAVES + F.wave, NGW = F.G * NWAVES;
    f32x4 g0[4], g1[4];
#pragma unroll
    for (int j = 0; j < 4; ++j) { g0[j] = *((const f32x4*)gf + 2 * (LN + 64 * j)); g1[j] = *((const f32x4*)gf + 2 * (LN + 64 * j) + 1); }
    for (int m = gw; m < T; m += NGW) { const u32x4* xr = (const u32x4*)(XB + (size_t)m * DM) + LN; f32x4* orow = (f32x4*)(F.out + (size_t)m * DM); const float r = rs_from(ss3[m], SSX_INV, 1.f / DM);
#pragma unroll
        for (int j = 0; j < 4; ++j) { const u32x4 w = xr[64 * j];
            orow[2 * (LN + 64 * j)] = (f32x4){bflo(w.x), bfhi(w.x), bflo(w.y), bfhi(w.y)} * r * g0[j]; orow[2 * (LN + 64 * j) + 1] = (f32x4){bflo(w.z), bfhi(w.z), bflo(w.w), bfhi(w.w)} * r * g1[j]; } }
}

constexpr int N_PHASES = 11;
struct Args { const float* in[26]; float* out; unsigned char* ws; int ph_lo, ph_hi; };
__global__ void __launch_bounds__(NWAVES * 64, 2) hymba_fwd(Args args) {
    extern __shared__ __attribute__((aligned(16))) unsigned char lds[];
    Frame F;
    F.lds = (LAS unsigned char*)lds;
    volatile LAS unsigned* MISC = (volatile LAS unsigned*)(F.lds + MISC_OFF);
    F.wave = __builtin_amdgcn_readfirstlane((int)threadIdx.x >> 6);
    F.G = gridDim.x; { const int bx = blockIdx.x; F.vcu = (F.G % 8 == 0) ? (bx % 8) * (F.G / 8) + bx / 8 : bx; }
    F.in = (InTab)__builtin_amdgcn_kernarg_segment_ptr();
    F.out = args.out; F.ws = args.ws;
    unsigned char* ws = args.ws;
    unsigned* ctl = (unsigned*)(ws + WS_CTL);
    for (int u = F.wave * 64 + lane_id_(); u < (LDS_BYTES - LDSCTL_OFF) / 4; u += NWAVES * 64) ((LAS unsigned*)(F.lds + LDSCTL_OFF))[u] = 0u;
    __syncthreads();
    const int lo = args.ph_lo, hi = args.ph_hi;
    const bool one = (hi - lo) > 1;
    XcdBarrier bar; bar.bar = ctl + CW_BAR; bar.x = 0; bar.st = nullptr; bar.wave = 0;
    if (one) bar = xcd_barrier_post(ctl + CW_BAR, MISC + 8, F.wave);
#ifndef PH_MASK
#define PH_MASK 0x7ff
#endif
#define IN(k) (((PH_MASK >> (k)) & 1) && lo <= (k) && (k) < hi)
#define GRID_BAR(k) do { if (IN(k) && IN((k) + 1)) xcd_barrier(bar); } while (0)
    bf16_t* XB = (bf16_t*)(ws + WS_XB); unsigned char* ACT = ws + WS_ACT; unsigned char* XB8 = ws + WS_XB8;
    unsigned* ss0 = (unsigned*)(ws + WS_SS0); unsigned* ss1 = (unsigned*)(ws + WS_SS1); unsigned* ss2 = (unsigned*)(ws + WS_SS2); unsigned* ss3 = (unsigned*)(ws + WS_SS3);
    unsigned* ssc = (unsigned*)(ws + WS_SSC); unsigned* ssn = (unsigned*)(ws + WS_SSN);

#ifndef PROBE_DUP
#define PROBE_DUP 0
#endif
#define DUP(k) ((PROBE_DUP >> (k)) & 1)
    if (IN(0)) { FRESH_IN(F); if (DUP(0)) { p0_prologue(F); if (one) xcd_barrier(bar); } p0_prologue(F); } GRID_BAR(0);
    if (IN(1)) { pg8::Gemm g{(const bf16_t*)XB8, (const bf16_t*)(ws + WS_WGU1), DM / 2, DM / 2, DM / 2}; pg8::StaticOrder S; S.init(T, 2 * FFP, F.G, (int)blockIdx.x, DM / 2, DM / 2);
        pg8::EpiSwiGLU E{ACT, ss0, (const float*)(ws + WS_ROWF), SW8_INV};
        pg8::gemm_phase<pg8::EpiSwiGLU, pg8::StaticOrder, true, 2>(F.lds, g, S, E, F.wave); } GRID_BAR(1);
    if (IN(2)) { FRESH_IN(F); pg8::Gemm g{(const bf16_t*)ACT, (const bf16_t*)(ws + WS_WD1), FFP / 2, FFP / 2, FFP / 2}; pg8::StaticOrder S; S.init(T, DM, F.G, (int)blockIdx.x, FFP / 2, FFP / 2);
        if (DUP(2)) { pg8::EpiResid<0> E2{F.in[0], XB, nullptr, ss0, nullptr, nullptr}; pg8::gemm_phase<pg8::EpiResid<0>, pg8::StaticOrder, true, 1>(F.lds, g, S, E2, F.wave); if (one) xcd_barrier(bar); }
        pg8::EpiResid<0> E{F.in[0], XB, XB8, ss1, nullptr, nullptr}; pg8::gemm_phase<pg8::EpiResid<0>, pg8::StaticOrder, true, 1>(F.lds, g, S, E, F.wave); } GRID_BAR(2);
    if (IN(3)) { constexpr int KD = DM / 2; pg8::Gemm g{(const bf16_t*)XB8, (const bf16_t*)(ws + WS_WIN), KD, KD, KD}; pg8::StaticOrder S; S.init(T, NWIN, F.G, (int)blockIdx.x, KD, KD);
        pg8::EpiWin E{ss1,
            (bf16_t*)(ws + WS_QRAW), (bf16_t*)(ws + WS_QROT), (bf16_t*)(ws + WS_KC), (bf16_t*)(ws + WS_VC), (bf16_t*)(ws + WS_KS), (bf16_t*)(ws + WS_VS), (bf16_t*)(ws + WS_KW), (bf16_t*)(ws + WS_VW),
            (bf16_t*)(ws + WS_U), (float*)(ws + WS_G)};
        pg8::gemm_phase<pg8::EpiWin, pg8::StaticOrder, true, 2>(F.lds, g, S, E, F.wave); } GRID_BAR(3);
    if (IN(4)) { FRESH_IN(F); if (F.vcu == 0) { const int TID = F.wave * 64 + lane_id_(); const float* b1p = (const float*)(ws + WS_B1) + 1024; float sacc = 0.f;
#pragma unroll
            for (int ch = 0; ch < 16; ++ch) sacc += b1p[((TID >> 8) * 16 + ch) * 256 + (TID & 255)];
            ((float*)(ws + WS_B1))[TID] = sacc; }
        conv_phase(F); vt8_phase(F);
        if (DUP(4)) { conv_phase(F); pg8::Gemm g{(const bf16_t*)(ws + WS_KC), (const bf16_t*)(ws + WS_WC1), 1024, 2048, 4096}; pg8::CmpOrder S{F.G, (int)blockIdx.x, (long)(WS_VC - WS_KC)};
            pg8::EpiCmpPart E{(float*)(ws + WS_CMPP)}; pg8::gemm_phase<pg8::EpiCmpPart, pg8::CmpOrder, false, 0>(F.lds, g, S, E, F.wave); if (one) xcd_barrier(bar); }
        pg8::Gemm g{(const bf16_t*)(ws + WS_KC), (const bf16_t*)(ws + WS_WC1), 1024, 2048, 4096}; pg8::CmpOrder S{F.G, (int)blockIdx.x, (long)(WS_VC - WS_KC)};
        pg8::EpiCmpPart E{(float*)(ws + WS_CMPP)}; pg8::gemm_phase<pg8::EpiCmpPart, pg8::CmpOrder, false, 0>(F.lds, g, S, E, F.wave); } GRID_BAR(4);
    if (IN(5)) { FRESH_IN(F); if (DUP(5)) { pg8::Gemm g{(const bf16_t*)(ws + WS_S1), (const bf16_t*)(ws + WS_WPW), CCH, CCH, CCH}; pg8::StaticOrder S; S.init(T, CCH, F.G, (int)blockIdx.x, CCH, CCH);
        pg8::EpiPw E{(void*)(ws + WS_MIXED), ss0}; pg8::gemm_phase<pg8::EpiPw, pg8::StaticOrder, false, 0>(F.lds, g, S, E, F.wave); cmp2_phase(F); if (one) xcd_barrier(bar); }
        { pg8::Gemm g{(const bf16_t*)(ws + WS_S1), (const bf16_t*)(ws + WS_WPW), CCH, CCH, CCH}; pg8::StaticOrder S; S.init(T, CCH, F.G, (int)blockIdx.x, CCH, CCH);
        pg8::EpiPw E{(void*)(ws + WS_MIXED), ssc}; pg8::gemm_phase<pg8::EpiPw, pg8::StaticOrder, false, 0>(F.lds, g, S, E, F.wave); }
        cmp2_phase(F); } GRID_BAR(5);
    if (IN(6)) { const att::AttnP P{(const bf16_t*)(ws + WS_QRAW), (const bf16_t*)(ws + WS_KCMP), (const bf16_t*)(ws + WS_VCMP), ws + WS_KS, ws + WS_KW, ws + WS_VTS, ws + WS_VTW,
            (const float*)(ws + WS_G), (void*)(ws + WS_MIXED), ssn};
        if (DUP(6)) { att::AttnP P2 = P; P2.ssn = ss0;
            for (int p = F.vcu; p < 12 * 64; p += F.G) { const int bg = p >> 6, x = p & 63, b = bg / NKV, g = bg % NKV;
                att::attn_unit(P2, b, g, x, (LAS char*)F.lds, F.wave); att::attn_unit(P2, b, g, 127 - x, (LAS char*)F.lds, F.wave); }
            if (one) xcd_barrier(bar); }
        for (int p = F.vcu, k = 0; p < 12 * 64; p += F.G, ++k) { const int bg = p >> 6, x = ((p & 63) + 21 * k) & 63, b = bg / NKV, g = bg % NKV;
            att::attn_unit(P, b, g, x, (LAS char*)F.lds, F.wave); att::attn_unit(P, b, g, 127 - x, (LAS char*)F.lds, F.wave); } } GRID_BAR(6);
    if (IN(7)) { constexpr int KO = OUT_FP8 ? DM / 2 : DM; pg8::Gemm g{(const bf16_t*)(ws + WS_MIXED), (const bf16_t*)(ws + WS_WOUT), KO, KO, KO}; pg8::StaticOrder S; S.init(T, DM, F.G, (int)blockIdx.x, KO, KO);
        pg8::EpiResid<1> E{nullptr, XB, XB8, ss2, ssc, ssn}; pg8::gemm_phase<pg8::EpiResid<1>, pg8::StaticOrder, true, OUT_FP8 ? 1 : 0>(F.lds, g, S, E, F.wave); } GRID_BAR(7);
    if (IN(8)) { pg8::Gemm g{(const bf16_t*)XB8, (const bf16_t*)(ws + WS_WGU2), DM / 2, DM / 2, DM / 2}; pg8::StaticOrder S; S.init(T, 2 * FFP, F.G, (int)blockIdx.x, DM / 2, DM / 2);
        pg8::EpiSwiGLU E{ACT, ss2, nullptr, SW8_INV / SA2}; pg8::gemm_phase<pg8::EpiSwiGLU, pg8::StaticOrder, true, 2>(F.lds, g, S, E, F.wave); } GRID_BAR(8);
    if (IN(9)) { pg8::Gemm g{(const bf16_t*)ACT, (const bf16_t*)(ws + WS_WD2), FFP / 2, FFP / 2, FFP / 2}; pg8::StaticOrder S; S.init(T, DM, F.G, (int)blockIdx.x, FFP / 2, FFP / 2);
        pg8::EpiResid<2> E{nullptr, XB, nullptr, ss3, nullptr, nullptr}; pg8::gemm_phase<pg8::EpiResid<2>, pg8::StaticOrder, true, 1>(F.lds, g, S, E, F.wave); } GRID_BAR(9);
    if (IN(10)) { FRESH_IN(F); final_phase(F); }
#undef IN
#undef GRID_BAR
}

extern "C" void kernel_launch(void* const* d_in, const int* in_sizes, int n_in, void* d_out, int out_size, void* d_ws, size_t ws_size, hipStream_t stream) {
    static int grid = 0;
    if (grid == 0) {
        if (n_in != 26 || in_sizes[0] != T * DM || out_size != T * DM || ws_size < WS_END) { fprintf(stderr, "kernel_launch: unexpected shapes (n_in %d, ws %zu)\n", n_in, ws_size); grid = -1; return; }
        int dev = 0, cus = 0, per_cu = 0;
        if (hipGetDevice(&dev) != hipSuccess || hipDeviceGetAttribute(&cus, hipDeviceAttributeMultiprocessorCount, dev) != hipSuccess) { grid = -1; return; }
        if (hipFuncSetAttribute((const void*)hymba_fwd, hipFuncAttributeMaxDynamicSharedMemorySize, LDS_BYTES) != hipSuccess) { grid = -1; return; }
        if (hipOccupancyMaxActiveBlocksPerMultiprocessor(&per_cu, (const void*)hymba_fwd, NWAVES * 64, LDS_BYTES) != hipSuccess || per_cu < 1) { fprintf(stderr, "kernel_launch: occupancy query says %d\n", per_cu); }
        (void)hipGetLastError();
        grid = cus;
    }
    if (grid < 0) return;
    if (hipMemsetAsync((char*)d_ws + WS_CTL, 0, CTL_ZERO_BYTES, stream) != hipSuccess) return;
    Args a{};
    for (int i = 0; i < 26; ++i) a.in[i] = (const float*)d_in[i];
    a.out = (float*)d_out; a.ws = (unsigned char*)d_ws;
#if MK_N_LAUNCHES == 1
    a.ph_lo = 0; a.ph_hi = N_PHASES;
    hipLaunchKernelGGL(hymba_fwd, dim3(grid), dim3(NWAVES * 64), LDS_BYTES, stream, a);
#else
    for (int p = 0; p < N_PHASES; ++p) { a.ph_lo = p; a.ph_hi = p + 1; hipLaunchKernelGGL(hymba_fwd, dim3(grid), dim3(NWAVES * 64), LDS_BYTES, stream, a); }
#endif
}
```

```cpp
#include <hip/hip_runtime.h>
#include <hip/hip_bf16.h>
#include <cstdio>
#include <cstdint>

#ifndef OUT_FP8
#define OUT_FP8 1
#endif
#ifndef MK_N_LAUNCHES
#define MK_N_LAUNCHES 1
#endif

#define GAS __attribute__((address_space(1)))
#define LAS __attribute__((address_space(3)))
typedef unsigned short bf16_t;
typedef short bf16x8 __attribute__((ext_vector_type(8)));
typedef short s16x4 __attribute__((ext_vector_type(4)));
typedef float f32x4 __attribute__((ext_vector_type(4)));
typedef float f32x2 __attribute__((ext_vector_type(2)));
typedef float f32x16 __attribute__((ext_vector_type(16)));
typedef unsigned u32x4 __attribute__((ext_vector_type(4)));
typedef unsigned u32x2 __attribute__((ext_vector_type(2)));

constexpr int BATCH = 4, SEQ = 8192, DM = 2048, T = BATCH * SEQ, FF = 5504, NH = 12, HD = 128, NKV = 3, CCH = 512, NIN = 4900;
constexpr int FFP = 5632;
constexpr float W8S = 64.f, W8S_INV = 1.f / 64.f;
constexpr float SW8 = 127.f * 45.254833995939045f / 5.5f, SW8_INV = 1.f / SW8, SA1 = 127.f / 5.75f, SA2 = 127.f / 8.f;
constexpr float A8C = 8.f, A8N = 16.f;
constexpr int NCP = 512;
constexpr int NWIN = 20 * 256;
constexpr float EPS = 1e-6f;
constexpr float SSX = 4096.f, SSX_INV = 1.f / 4096.f;
constexpr float SSC = 65536.f, SSC_INV = 1.f / 65536.f;
constexpr float SSN = 262144.f, SSN_INV = 1.f / 262144.f;

constexpr size_t MiB = 1u << 20;
constexpr size_t WS_CTL = 0, CTL_ZERO_BYTES = 2 * MiB;
constexpr size_t WS_SS1 = 1 * MiB, WS_SS2 = WS_SS1 + 131072, WS_SS3 = WS_SS2 + 131072, WS_SSC = WS_SS3 + 131072, WS_SSN = WS_SSC + 131072;
constexpr size_t WS_SS0 = 2 * MiB, WS_B1 = 2 * MiB + 262144, WS_ROWF = 2 * MiB + 524288;
constexpr size_t WS_WGU1 = 8 * MiB, WS_WD1 = 30 * MiB, WS_WGU2 = 41 * MiB, WS_WD2 = 63 * MiB;
constexpr size_t WS_XB8 = 74 * MiB;
constexpr size_t WS_WIN = 138 * MiB, WS_WOUT = 158 * MiB, WS_WC1 = 166 * MiB, WS_WPW = 170 * MiB;
constexpr size_t WS_XB = 172 * MiB;
constexpr size_t WS_ACT = 300 * MiB;
constexpr size_t WS_QRAW = 300 * MiB, WS_QROT = 396 * MiB, WS_KC = 492 * MiB, WS_VC = 517 * MiB, WS_KS = 542 * MiB, WS_VS = 566 * MiB, WS_KW = 590 * MiB, WS_VW = 614 * MiB;
constexpr size_t WS_U = 638 * MiB, WS_S1 = 670 * MiB, WS_G = 702 * MiB, WS_MIXED = 708 * MiB, WS_CMPP = 836 * MiB, WS_KCMP = 884 * MiB, WS_VCMP = 886 * MiB;
constexpr size_t WS_VTS = 396 * MiB, WS_VTW = 408 * MiB;
constexpr size_t WS_END = 888 * MiB;
constexpr int GLD = 40;

constexpr int CW_BAR = 4096;

constexpr int RING_BYTES = 131072;
constexpr int LDSCTL_OFF = 143360 - 1024, MISC_OFF = LDSCTL_OFF + 320;
constexpr int LDS_BYTES = 147456;
constexpr int NWAVES = 8;

#define LDS_WAIT() asm volatile("s_waitcnt lgkmcnt(0)" ::: "memory")
#define VM_WAIT() asm volatile("s_waitcnt vmcnt(0)" ::: "memory")
#define SBAR() __builtin_amdgcn_sched_barrier(0)

__device__ __forceinline__ int lane_id_() { int l; asm volatile("v_mbcnt_lo_u32_b32 %0, -1, 0\n\tv_mbcnt_hi_u32_b32 %0, -1, %0" : "=v"(l)); return l; }
__device__ __forceinline__ unsigned cvtpk(float lo, float hi) { unsigned r; asm volatile("v_cvt_pk_bf16_f32 %0, %1, %2" : "=v"(r) : "v"(lo), "v"(hi)); return r; }
__device__ __forceinline__ float clamp448(float v) { return __builtin_amdgcn_fmed3f(v, -448.f, 448.f); }
__device__ __forceinline__ u32x2 pk8_fp8(const float* v) {
    unsigned w0 = 0u, w1 = 0u;
    w0 = __builtin_amdgcn_cvt_pk_fp8_f32(clamp448(v[0]), clamp448(v[1]), w0, false); w0 = __builtin_amdgcn_cvt_pk_fp8_f32(clamp448(v[2]), clamp448(v[3]), w0, true);
    w1 = __builtin_amdgcn_cvt_pk_fp8_f32(clamp448(v[4]), clamp448(v[5]), w1, false); w1 = __builtin_amdgcn_cvt_pk_fp8_f32(clamp448(v[6]), clamp448(v[7]), w1, true);
    return (u32x2){w0, w1};
}
__device__ __forceinline__ u32x2 pk8_i8(const float* v, float scale) {
    unsigned t[8];
#pragma unroll
    for (int j = 0; j < 8; ++j) t[j] = __float_as_uint(__builtin_amdgcn_fmed3f(v[j] * scale, -127.f, 127.f) + 12582912.f);
    const unsigned lo = __builtin_amdgcn_perm(__builtin_amdgcn_perm(t[3], t[2], 0x0c0c0400u) << 16, __builtin_amdgcn_perm(t[1], t[0], 0x0c0c0400u), 0x07060100u);
    const unsigned hi = __builtin_amdgcn_perm(__builtin_amdgcn_perm(t[7], t[6], 0x0c0c0400u) << 16, __builtin_amdgcn_perm(t[5], t[4], 0x0c0c0400u), 0x07060100u);
    return (u32x2){lo, hi};
}
__device__ __forceinline__ float bf2f(unsigned short h) { return __uint_as_float((unsigned)h << 16); }
__device__ __forceinline__ float bflo(unsigned w) { return __uint_as_float(w << 16); }
__device__ __forceinline__ float bfhi(unsigned w) { return __uint_as_float(w & 0xffff0000u); }
__device__ __forceinline__ float wave_sum(float v) {
    v += __builtin_bit_cast(float, __builtin_amdgcn_update_dpp(0, __builtin_bit_cast(int, v), 0xB1, 0xF, 0xF, true));
    v += __builtin_bit_cast(float, __builtin_amdgcn_update_dpp(0, __builtin_bit_cast(int, v), 0x4E, 0xF, 0xF, true));
    v += __builtin_bit_cast(float, __builtin_amdgcn_update_dpp(0, __builtin_bit_cast(int, v), 0x141, 0xF, 0xF, true));
    v += __builtin_bit_cast(float, __builtin_amdgcn_update_dpp(0, __builtin_bit_cast(int, v), 0x140, 0xF, 0xF, true));
    { auto rr = __builtin_amdgcn_permlane16_swap(__float_as_uint(v), __float_as_uint(v), false, false); v = __uint_as_float(rr[0]) + __uint_as_float(rr[1]); }
    { auto rr = __builtin_amdgcn_permlane32_swap(__float_as_uint(v), __float_as_uint(v), false, false); v = __uint_as_float(rr[0]) + __uint_as_float(rr[1]); }
    return v;
}
template <int CTRL> __device__ __forceinline__ float dppf(float v) { return __builtin_bit_cast(float, __builtin_amdgcn_update_dpp(0, __builtin_bit_cast(int, v), CTRL, 0xF, 0xF, true)); }
template <int CTRL> __device__ __forceinline__ unsigned dppu(unsigned v) { return (unsigned)__builtin_amdgcn_update_dpp(0, (int)v, CTRL, 0xF, 0xF, true); }
#define DPP_X1 0xB1
#define DPP_X2 0x4E
#define DPP_HM 0x141
#define DPP_RM 0x140
__device__ __forceinline__ float sigmoidf_(float v) { return __builtin_amdgcn_rcpf(1.f + __builtin_amdgcn_exp2f(-1.4426950408889634f * v)); }
__device__ __forceinline__ float siluf_(float v) { return v * sigmoidf_(v); }
__device__ __forceinline__ float rs_from(unsigned ss, float inv_scale, float inv_n) { return __builtin_amdgcn_rsqf((float)ss * (inv_scale * inv_n) + EPS); }
__device__ __forceinline__ unsigned fixu(float v, float scale) { return (unsigned)(v * scale + 0.5f); }

namespace pg8 {
constexpr int BM = 256, BK = 64, HALF = 128, HTB = HALF * BK * 2, NXCD = 8, WGM = 4;
__host__ __device__ __forceinline__ int lds_byte(int r, int c) { const int st = (r >> 4) * 2 + (c >> 5), rr = r & 15, cc = c & 31, ob = rr * 64 + cc * 2; return st * 1024 + (ob ^ (((ob >> 9) & 1) << 5)); }
__host__ __device__ __forceinline__ void stage_rc(int b, int& R, int& C) { const int st = b / 1024, sb = b % 1024, swz = sb ^ (((sb >> 9) & 1) << 5); R = (st >> 1) * 16 + swz / 64; C = (st & 1) * 32 + (swz % 64) / 2; }
__host__ __device__ __forceinline__ int perm32(int rho) { const int n = rho >> 4, i = rho & 15; return 8 * (i >> 2) + 4 * n + (i & 3); }

typedef int i32x8 __attribute__((ext_vector_type(8)));
typedef int i32x4 __attribute__((ext_vector_type(4)));
typedef short s16x16 __attribute__((ext_vector_type(16)));
__device__ __forceinline__ i32x8 cat8(bf16x8 a, bf16x8 b) { return __builtin_bit_cast(i32x8, __builtin_shufflevector(a, b, 0, 1, 2, 3, 4, 5, 6, 7, 8, 9, 10, 11, 12, 13, 14, 15)); }
__device__ __forceinline__ bf16x8 lo8(i32x8 v) { return __builtin_bit_cast(bf16x8, __builtin_shufflevector(v, v, 0, 1, 2, 3)); }
__device__ __forceinline__ bf16x8 hi8(i32x8 v) { return __builtin_bit_cast(bf16x8, __builtin_shufflevector(v, v, 4, 5, 6, 7)); }
struct Unit { int pm, pn; long ao, bo; int aux; };
struct Gemm { const bf16_t* A; const bf16_t* Bt; int K, lda, ldb; };

struct StaticOrder {
    int nM, nN, nwg, G, c; long ta, tb;
    __device__ void init(int M, int N, int G_, int c_, int lda, int ldb) { nM = M / BM; nN = N / BM; nwg = nM * nN; G = G_; c = c_; ta = (long)BM * lda * 2; tb = (long)BM * ldb * 2; }
    __device__ bool next(int i, Unit& u) const {
        const long L = (long)i * G + c; if (L >= nwg) return false;
        int wgid = (int)L; { const int q = nwg / NXCD, r = nwg % NXCD, xcd = wgid % NXCD, off = wgid / NXCD; wgid = (xcd < r ? xcd * (q + 1) : r * (q + 1) + (xcd - r) * q) + off; }
        const int nig = WGM * nN, gid = wgid / nig, fm = gid * WGM, gsz = (nM - fm) < WGM ? (nM - fm) : WGM;
        u.pm = fm + ((wgid % nig) % gsz); u.pn = (wgid % nig) / gsz; u.ao = u.pm * ta; u.bo = u.pn * tb; u.aux = 0; return true;
    }
    __device__ __forceinline__ void a_ready(const Unit&) const {}
    __device__ __forceinline__ void done(const Unit&) const {}
};

template <class Epi, class Sched, bool ALIGN_EPI = false, int PREC = 0>
__device__ __forceinline__ void gemm_phase(LAS unsigned char* lds, const Gemm g, const Sched& S, const Epi& E, int wid) {
    const int lane = lane_id_(), tid = wid * 64 + lane, wr = wid >> 2, wc = wid & 3, fr = lane & 15, fq = lane >> 4;
    const int K = g.K, nt = K / BK;
    unsigned voffA[2], voffB[2];
#pragma unroll
    for (int i = 0; i < 2; ++i) { int R, C; stage_rc(tid * 16 + i * 8192, R, C); const int Rb = (R & ~31) + perm32(R & 31);
        voffA[i] = (unsigned)(R * g.lda + C) * 2u; voffB[i] = (unsigned)(Rb * g.ldb + C) * 2u; }
    const size_t kstep = (size_t)(BK * 2);
    const size_t hstepA = (size_t)HALF * g.lda * 2, hstepB = (size_t)HALF * g.ldb * 2;
    const unsigned ldsw = (unsigned)wid * 1024u;
    const int aoff = lds_byte(wr * 64 + fr, fq * 8), boff = lds_byte(wc * 32 + fr, fq * 8);
#define PG8_SA(b, h) (((b) * 2 + (h)) * HTB)
#define PG8_SB(b, h) ((4 + (b) * 2 + (h)) * HTB)
#define PG8_STAGE(bufoff, gbase, voff) do { _Pragma("unroll") for (int _i = 0; _i < 2; ++_i) \
        __builtin_amdgcn_global_load_lds((const unsigned*)((const char*)(gbase) + (voff)[_i]), (LAS unsigned*)(lds + (bufoff) + ldsw + _i * 8192), 16, 0, 0); } while (0)
#define PG8_LDA(dst, b, h) do { _Pragma("unroll") for (int m = 0; m < 4; ++m) { const bf16x8 f0_ = *(const LAS bf16x8*)(lds + PG8_SA(b, h) + aoff + m * 2048), f1_ = *(const LAS bf16x8*)(lds + PG8_SA(b, h) + aoff + m * 2048 + 1024); dst[m] = cat8(f0_, f1_); } } while (0)
#define PG8_LDB(dst, b, h) do { _Pragma("unroll") for (int n = 0; n < 2; ++n) { const bf16x8 f0_ = *(const LAS bf16x8*)(lds + PG8_SB(b, h) + boff + n * 2048), f1_ = *(const LAS bf16x8*)(lds + PG8_SB(b, h) + boff + n * 2048 + 1024); dst[n] = cat8(f0_, f1_); } } while (0)
#define PG8_MMA(ai, bj, At, Bt) do { __builtin_amdgcn_s_setprio(1); _Pragma("unroll") for (int m = 0; m < 4; ++m) _Pragma("unroll") for (int n = 0; n < 2; ++n) { \
        if constexpr (PREC == 1) { asm volatile("v_mfma_scale_f32_16x16x128_f8f6f4 %0, %1, %2, %0, %3, %3 op_sel_hi:[0,0,0]" : "+v"(acc[ai][bj][m][n]) : "v"(Bt[n]), "v"(At[m]), "v"(sc1)); } \
        else if constexpr (PREC == 2) { i32x4 c_ = __builtin_bit_cast(i32x4, acc[ai][bj][m][n]); \
               c_ = __builtin_amdgcn_mfma_i32_16x16x64_i8(__builtin_bit_cast(i32x4, lo8(Bt[n])), __builtin_bit_cast(i32x4, lo8(At[m])), c_, 0, 0, 0); \
               c_ = __builtin_amdgcn_mfma_i32_16x16x64_i8(__builtin_bit_cast(i32x4, hi8(Bt[n])), __builtin_bit_cast(i32x4, hi8(At[m])), c_, 0, 0, 0); acc[ai][bj][m][n] = __builtin_bit_cast(f32x4, c_); } \
        else { acc[ai][bj][m][n] = __builtin_amdgcn_mfma_f32_16x16x32_bf16(lo8(Bt[n]), lo8(At[m]), acc[ai][bj][m][n], 0, 0, 0); \
               acc[ai][bj][m][n] = __builtin_amdgcn_mfma_f32_16x16x32_bf16(hi8(Bt[n]), hi8(At[m]), acc[ai][bj][m][n], 0, 0, 0); } } \
        __builtin_amdgcn_s_setprio(0); } while (0)
#define PG8_WAIT_V(n) asm volatile("s_waitcnt vmcnt(" #n ")" ::: "memory")
#define PG8_WAIT_L(n) asm volatile("s_waitcnt lgkmcnt(" #n ")" ::: "memory")
#define PG8_BAR __builtin_amdgcn_s_barrier()
#define PG8_SCHED __builtin_amdgcn_sched_barrier(0)
    Unit cur, nxt; int ui = 0;
    if (!S.next(0, cur)) return;
    f32x4 acc[2][2][4][2];
#pragma unroll
    for (int a = 0; a < 2; ++a)
#pragma unroll
        for (int b = 0; b < 2; ++b)
#pragma unroll
            for (int m = 0; m < 4; ++m)
#pragma unroll
                for (int n = 0; n < 2; ++n) acc[a][b][m][n] = (f32x4){0.f, 0.f, 0.f, 0.f};
    i32x8 At[4], B0[2], B1[2]; const unsigned sc1 = 0x7f7f7f7fu;
    const char* cA = (const char*)g.A + cur.ao; const char* cB = (const char*)g.Bt + cur.bo;
    S.a_ready(cur);
    PG8_STAGE(PG8_SB(0, 0), cB, voffB); PG8_STAGE(PG8_SB(0, 1), cB + hstepB, voffB); PG8_STAGE(PG8_SA(0, 0), cA, voffA); PG8_STAGE(PG8_SA(0, 1), cA + hstepA, voffA);
    if (wr == 1) PG8_BAR;
    PG8_WAIT_V(2); PG8_BAR;
    PG8_STAGE(PG8_SB(1, 0), cB + kstep, voffB); PG8_STAGE(PG8_SA(1, 0), cA + kstep, voffA); PG8_STAGE(PG8_SB(1, 1), cB + hstepB + kstep, voffB);
    PG8_WAIT_V(6); PG8_BAR;
    for (;;) {
        const bool has_next = S.next(ui + 1, nxt);
        const char* nA = has_next ? (const char*)g.A + nxt.ao : cA; const char* nB = has_next ? (const char*)g.Bt + nxt.bo : cB;
        int tb = 0;
#pragma unroll 1
        for (int seg = 0; seg < (Epi::MID_TILE > 0 ? 2 : 1); ++seg) {
        const int te = (Epi::MID_TILE > 0 && seg == 0) ? Epi::MID_TILE : nt;
        if constexpr (Epi::MID_TILE > 0) { if (seg == 1) { PG8_SCHED; E.mid(acc, cur, wr, fr); PG8_SCHED; } }
#pragma unroll 1
        for (int t = tb; t < te; t += 2) {
            const bool last = (t == nt - 2);
            const char* a1 = cA + (size_t)(t + 1) * kstep;
            const char* a2 = last ? nA : cA + (size_t)(t + 2) * kstep; const char* b2 = last ? nB : cB + (size_t)(t + 2) * kstep;
            const char* a3 = a2 + kstep; const char* b3 = b2 + kstep;
            if (last && has_next) S.a_ready(nxt);
            PG8_LDB(B0, 0, 0); PG8_LDB(B1, 0, 1); PG8_SCHED; PG8_LDA(At, 0, 0); PG8_STAGE(PG8_SA(1, 1), a1 + hstepA, voffA);
            PG8_WAIT_V(8); PG8_WAIT_L(0); PG8_BAR; PG8_MMA(0, 0, At, B0); PG8_MMA(0, 1, At, B1); PG8_BAR; PG8_SCHED;
            PG8_LDA(At, 0, 1); PG8_STAGE(PG8_SB(0, 0), b2, voffB); PG8_STAGE(PG8_SB(0, 1), b2 + hstepB, voffB); PG8_STAGE(PG8_SA(0, 0), a2, voffA);
            PG8_WAIT_V(8); PG8_WAIT_L(0); PG8_BAR; PG8_MMA(1, 0, At, B0); PG8_MMA(1, 1, At, B1); PG8_BAR; PG8_SCHED;
            PG8_LDB(B0, 1, 0); PG8_LDB(B1, 1, 1); PG8_SCHED; PG8_LDA(At, 1, 0); PG8_STAGE(PG8_SA(0, 1), a2 + hstepA, voffA);
            PG8_WAIT_V(8); PG8_WAIT_L(0); PG8_BAR; PG8_MMA(0, 0, At, B0); PG8_MMA(0, 1, At, B1); PG8_BAR; PG8_SCHED;
            PG8_LDA(At, 1, 1); PG8_STAGE(PG8_SB(1, 0), b3, voffB); PG8_STAGE(PG8_SB(1, 1), b3 + hstepB, voffB); PG8_STAGE(PG8_SA(1, 0), a3, voffA);
            PG8_WAIT_V(8); PG8_WAIT_L(0); PG8_BAR; PG8_MMA(1, 0, At, B0); PG8_MMA(1, 1, At, B1); PG8_BAR; PG8_SCHED;
        }
        tb = te;
        }
        if constexpr (ALIGN_EPI) { if (wr == 0) PG8_BAR; }
        if constexpr (PREC == 1) asm volatile("s_nop 15\n\ts_nop 15" ::: "memory");
        if constexpr (PREC == 2) {
#pragma unroll
            for (int a = 0; a < 2; ++a)
#pragma unroll
                for (int b = 0; b < 2; ++b)
#pragma unroll
                    for (int m = 0; m < 4; ++m)
#pragma unroll
                        for (int n = 0; n < 2; ++n) acc[a][b][m][n] = __builtin_convertvector(__builtin_bit_cast(i32x4, acc[a][b][m][n]), f32x4); }
        E(acc, cur, wr, wc, fr, fq); S.done(cur);
        if (!has_next) break;
#pragma unroll
        for (int a = 0; a < 2; ++a)
#pragma unroll
            for (int b = 0; b < 2; ++b)
#pragma unroll
                for (int m = 0; m < 4; ++m)
#pragma unroll
                    for (int n = 0; n < 2; ++n) acc[a][b][m][n] = (f32x4){0.f, 0.f, 0.f, 0.f};
        cur = nxt; cA = nA; cB = nB; ++ui;
        if constexpr (ALIGN_EPI) { if (wr == 1) PG8_BAR; }
    }
    PG8_WAIT_V(0);
    if constexpr (!ALIGN_EPI) { if (wr == 0) PG8_BAR; }
    PG8_BAR;
#undef PG8_SA
#undef PG8_SB
#undef PG8_STAGE
#undef PG8_LDA
#undef PG8_LDB
#undef PG8_MMA
#undef PG8_WAIT_V
#undef PG8_WAIT_L
#undef PG8_BAR
#undef PG8_SCHED
}

typedef const f32x4 (&AccRef)[2][2][4][2];

struct EpiSwiGLU {
    static constexpr int MID_TILE = 0;
    unsigned char* O; const unsigned* ss; const float* rowf; float cf;
    __device__ __forceinline__ void mid(f32x4 (&)[2][2][4][2], const Unit&, int, int) const {}
    __device__ __forceinline__ void operator()(AccRef acc, const Unit& u, int wr, int wc, int fr, int fq) const {
        int row0 = u.pm * BM + wr * 64 + fr; asm volatile("" : "+v"(row0)); const int col0 = u.pn * 128 + wc * 32 + 8 * fq;
        unsigned sv[8];
#pragma unroll
        for (int q = 0; q < 8; ++q) sv[q] = ss[row0 + (q >> 2) * HALF + (q & 3) * 16];
        asm volatile("" ::: "memory");
#pragma unroll
        for (int ai = 0; ai < 2; ++ai)
#pragma unroll
            for (int m = 0; m < 4; ++m) { const int row = row0 + ai * HALF + m * 16; const float r = rs_from(sv[ai * 4 + m], SSX_INV, 1.f / DM) * cf * (rowf ? rowf[row] : 1.f), r2 = r * -1.4426950408889634f, rr = r * r;
                float o[8], gq[8], uq[8];
#pragma unroll
                for (int n = 0; n < 2; ++n)
#pragma unroll
                    for (int e = 0; e < 4; ++e) { gq[4 * n + e] = acc[ai][0][m][n][e]; uq[4 * n + e] = acc[ai][1][m][n][e]; }
                asm("v_mul_f32 %0, %8, %24\n\tv_mul_f32 %1, %9, %24\n\tv_mul_f32 %2, %10, %24\n\tv_mul_f32 %3, %11, %24\n\tv_mul_f32 %4, %12, %24\n\tv_mul_f32 %5, %13, %24\n\tv_mul_f32 %6, %14, %24\n\tv_mul_f32 %7, %15, %24\n\t"
                    "v_exp_f32 %0, %0\n\tv_exp_f32 %1, %1\n\tv_exp_f32 %2, %2\n\tv_exp_f32 %3, %3\n\tv_exp_f32 %4, %4\n\tv_exp_f32 %5, %5\n\tv_exp_f32 %6, %6\n\tv_exp_f32 %7, %7\n\t"
                    "v_mul_f32 %8, %8, %16\n\tv_mul_f32 %9, %9, %17\n\tv_mul_f32 %10, %10, %18\n\tv_mul_f32 %11, %11, %19\n\tv_mul_f32 %12, %12, %20\n\tv_mul_f32 %13, %13, %21\n\tv_mul_f32 %14, %14, %22\n\tv_mul_f32 %15, %15, %23\n\t"
                    "v_add_f32 %0, 1.0, %0\n\tv_add_f32 %1, 1.0, %1\n\tv_add_f32 %2, 1.0, %2\n\tv_add_f32 %3, 1.0, %3\n\tv_add_f32 %4, 1.0, %4\n\tv_add_f32 %5, 1.0, %5\n\tv_add_f32 %6, 1.0, %6\n\tv_add_f32 %7, 1.0, %7\n\t"
                    "v_mul_f32 %8, %8, %25\n\tv_mul_f32 %9, %9, %25\n\tv_mul_f32 %10, %10, %25\n\tv_mul_f32 %11, %11, %25\n\tv_mul_f32 %12, %12, %25\n\tv_mul_f32 %13, %13, %25\n\tv_mul_f32 %14, %14, %25\n\tv_mul_f32 %15, %15, %25\n\t"
                    "v_rcp_f32 %0, %0\n\tv_rcp_f32 %1, %1\n\tv_rcp_f32 %2, %2\n\tv_rcp_f32 %3, %3\n\tv_rcp_f32 %4, %4\n\tv_rcp_f32 %5, %5\n\tv_rcp_f32 %6, %6\n\tv_rcp_f32 %7, %7\n\t"
                    "v_mul_f32 %0, %0, %8\n\tv_mul_f32 %1, %1, %9\n\tv_mul_f32 %2, %2, %10\n\tv_mul_f32 %3, %3, %11\n\tv_mul_f32 %4, %4, %12\n\tv_mul_f32 %5, %5, %13\n\tv_mul_f32 %6, %6, %14\n\tv_mul_f32 %7, %7, %15"
                    : "=&v"(o[0]), "=&v"(o[1]), "=&v"(o[2]), "=&v"(o[3]), "=&v"(o[4]), "=&v"(o[5]), "=&v"(o[6]), "=&v"(o[7]),
                      "+v"(gq[0]), "+v"(gq[1]), "+v"(gq[2]), "+v"(gq[3]), "+v"(gq[4]), "+v"(gq[5]), "+v"(gq[6]), "+v"(gq[7])
                    : "v"(uq[0]), "v"(uq[1]), "v"(uq[2]), "v"(uq[3]), "v"(uq[4]), "v"(uq[5]), "v"(uq[6]), "v"(uq[7]), "v"(r2), "v"(rr));
                *(u32x2*)(O + (size_t)row * FFP + col0) = pk8_fp8(o); }
    }
};

template <int MODE> struct EpiResid {
    static constexpr int MID_TILE = MODE == 1 ? (OUT_FP8 ? CCH / 128 : CCH / BK) : 0;
    const float* xf; bf16_t* xb; unsigned char* x8; unsigned* ss; const unsigned* ssc; const unsigned* ssn;
    __device__ __forceinline__ void mid(f32x4 (&acc)[2][2][4][2], const Unit& u, int wr, int fr) const {
        if constexpr (MODE == 1) {
            int row0 = u.pm * BM + wr * 64 + fr; asm volatile("" : "+v"(row0));
#pragma unroll
            for (int ai = 0; ai < 2; ++ai)
#pragma unroll
                for (int m = 0; m < 4; ++m) { const int row = row0 + ai * HALF + m * 16;
                    const float f = rs_from(ssc[row], SSC_INV, 1.f / CCH) * __builtin_amdgcn_sqrtf((float)ssn[row] * (SSN_INV / (NH * HD)) + EPS) * (OUT_FP8 ? A8N / A8C : 1.f);
#pragma unroll
                    for (int bj = 0; bj < 2; ++bj)
#pragma unroll
                        for (int n = 0; n < 2; ++n) acc[ai][bj][m][n] *= f;
                    __builtin_amdgcn_sched_barrier(0); }
        }
    }
    __device__ __forceinline__ void operator()(AccRef acc, const Unit& u, int wr, int wc, int fr, int fq) const {
        int row0 = u.pm * BM + wr * 64 + fr; asm volatile("" : "+v"(row0)); const int col0 = u.pn * BM + wc * 32 + 8 * fq;
#pragma unroll
        for (int ai = 0; ai < 2; ++ai) {
            f32x4 xv[4][2][2]; float scv[4];
#pragma unroll
            for (int m = 0; m < 4; ++m) { const int row = row0 + ai * HALF + m * 16;
                scv[m] = W8S_INV; if constexpr (MODE == 1) scv[m] = rs_from(ssn[row], SSN_INV, 1.f / (NH * HD)) * (OUT_FP8 ? W8S_INV / A8N : 1.f);
#pragma unroll
                for (int bj = 0; bj < 2; ++bj) { const size_t idx = (size_t)row * DM + col0 + bj * HALF;
                    if constexpr (MODE == 0) { xv[m][bj][0] = *(const f32x4*)(xf + idx); xv[m][bj][1] = *(const f32x4*)(xf + idx + 4); }
                    else { const u32x4 w = *(const u32x4*)(xb + idx); xv[m][bj][0] = (f32x4){bflo(w.x), bfhi(w.x), bflo(w.y), bfhi(w.y)}; xv[m][bj][1] = (f32x4){bflo(w.z), bfhi(w.z), bflo(w.w), bfhi(w.w)}; } } }
            asm volatile("" ::: "memory");
#pragma unroll
            for (int m = 0; m < 4; ++m) { const int row = row0 + ai * HALF + m * 16; const float sc = scv[m];
                float sq = 0.f;
#pragma unroll
                for (int bj = 0; bj < 2; ++bj) { const size_t idx = (size_t)row * DM + col0 + bj * HALF;
                    const f32x4 y0 = xv[m][bj][0] + acc[ai][bj][m][0] * sc, y1 = xv[m][bj][1] + acc[ai][bj][m][1] * sc;
                    { u32x4 w; w.x = cvtpk(y0[0], y0[1]); w.y = cvtpk(y0[2], y0[3]); w.z = cvtpk(y1[0], y1[1]); w.w = cvtpk(y1[2], y1[3]); *(u32x4*)(xb + idx) = w; }
                    if constexpr (MODE != 2) { const float yv[8] = {y0[0], y0[1], y0[2], y0[3], y1[0], y1[1], y1[2], y1[3]}; *(u32x2*)(x8 + idx) = pk8_i8(yv, MODE == 0 ? SA1 : SA2); }
                    sq += (y0[0] * y0[0] + y0[1] * y0[1]) + (y0[2] * y0[2] + y0[3] * y0[3]) + (y1[0] * y1[0] + y1[1] * y1[1]) + (y1[2] * y1[2] + y1[3] * y1[3]); }
                sq += __shfl_xor(sq, 16); sq += __shfl_xor(sq, 32);
                if (fq == 0) atomicAdd(ss + row, fixu(sq, SSX)); }
        }
    }
};

struct EpiPw {
    static constexpr int MID_TILE = 0;
    void* O; unsigned* ssc;
    __device__ __forceinline__ void mid(f32x4 (&)[2][2][4][2], const Unit&, int, int) const {}
    __device__ __forceinline__ void operator()(AccRef acc, const Unit& u, int wr, int wc, int fr, int fq) const {
        int row0 = u.pm * BM + wr * 64 + fr; asm volatile("" : "+v"(row0)); const int col0 = u.pn * BM + wc * 32 + 8 * fq;
#pragma unroll
        for (int ai = 0; ai < 2; ++ai)
#pragma unroll
            for (int m = 0; m < 4; ++m) { const int row = row0 + ai * HALF + m * 16; float sq = 0.f;
#pragma unroll
                for (int bj = 0; bj < 2; ++bj) { const f32x4 y0 = acc[ai][bj][m][0], y1 = acc[ai][bj][m][1];
                    if constexpr (OUT_FP8) { const float yv[8] = {y0[0] * A8C, y0[1] * A8C, y0[2] * A8C, y0[3] * A8C, y1[0] * A8C, y1[1] * A8C, y1[2] * A8C, y1[3] * A8C};
                        *(u32x2*)((unsigned char*)O + (size_t)row * DM + col0 + bj * HALF) = pk8_fp8(yv); }
                    else { u32x4 w; w.x = cvtpk(y0[0], y0[1]); w.y = cvtpk(y0[2], y0[3]); w.z = cvtpk(y1[0], y1[1]); w.w = cvtpk(y1[2], y1[3]);
                        *(u32x4*)((bf16_t*)O + (size_t)row * DM + col0 + bj * HALF) = w; }
                    sq += (y0[0] * y0[0] + y0[1] * y0[1]) + (y0[2] * y0[2] + y0[3] * y0[3]) + (y1[0] * y1[0] + y1[1] * y1[1]) + (y1[2] * y1[2] + y1[3] * y1[3]); }
                sq += __shfl_xor(sq, 16); sq += __shfl_xor(sq, 32);
                if (fq == 0) atomicAdd(ssc + row, fixu(sq, SSC)); }
    }
};

struct EpiCmpPart {
    static constexpr int MID_TILE = 0;
    float* P;
    __device__ __forceinline__ void mid(f32x4 (&)[2][2][4][2], const Unit&, int, int) const {}
    __device__ __forceinline__ void operator()(AccRef acc, const Unit& u, int wr, int wc, int fr, int fq) const {
        int row0 = u.pm * BM + wr * 64 + fr; asm volatile("" : "+v"(row0)); const int col0 = wc * 32 + 8 * fq; float* base = P + (size_t)u.aux * (12 * NCP) * 256;
#pragma unroll
        for (int ai = 0; ai < 2; ++ai)
#pragma unroll
            for (int m = 0; m < 4; ++m) { float* rowp = base + (size_t)(row0 + ai * HALF + m * 16) * 256 + col0;
#pragma unroll
                for (int bj = 0; bj < 2; ++bj) { *(f32x4*)(rowp + bj * HALF) = acc[ai][bj][m][0]; *(f32x4*)(rowp + bj * HALF + 4) = acc[ai][bj][m][1]; } }
    }
};
struct CmpOrder {
    int G, c; long akv;
    __device__ bool next(int i, Unit& u) const {
        const int L = i * G + c; if (L >= 192) return false;
        const int kv = L / 96, r = L % 96, ks = r / 24, pm = r % 24;
        u.pm = pm; u.pn = 0; u.aux = kv * 4 + ks;
        u.ao = kv * akv + ((long)pm * 256 * 2048 + ks * 1024) * 2; u.bo = ((long)kv * 256 * 4096 + ks * 1024) * 2; return true;
    }
    __device__ __forceinline__ void a_ready(const Unit&) const {}
    __device__ __forceinline__ void done(const Unit&) const {}
};

struct EpiWin {
    static constexpr int MID_TILE = 0;
    const unsigned* ss;
    bf16_t *QRAW, *QROT, *KC, *VC, *KS, *VS, *KW, *VW, *U; float* G;
    __device__ __forceinline__ void mid(f32x4 (&)[2][2][4][2], const Unit&, int, int) const {}
    __device__ __forceinline__ void operator()(AccRef acc, const Unit& u, int wr, int wc, int fr, int fq) const {
        int row0 = u.pm * BM + wr * 64 + fr; asm volatile("" : "+v"(row0)); const int pn = u.pn;
        float invr[8];
#pragma unroll
        for (int j = 0; j < 8; ++j) invr[j] = exp2f(-(float)(32 * (wc & 1) + 8 * fq + j) * (13.287712379549449f / 64.f)) * 0.15915494309189535f;
        unsigned sv[8];
#pragma unroll
        for (int q = 0; q < 8; ++q) sv[q] = ss[row0 + (q >> 2) * HALF + (q & 3) * 16];
        asm volatile("" ::: "memory");
#pragma unroll
        for (int ai = 0; ai < 2; ++ai)
#pragma unroll
            for (int m = 0; m < 4; ++m) { const int row = row0 + ai * HALF + m * 16; const float r = rs_from(sv[ai * 4 + m], SSX_INV, 1.f / DM) * (SW8_INV / SA1);
                const int bb = row >> 13, s = row & (SEQ - 1);
                float a0[8], a1[8];
#pragma unroll
                for (int n = 0; n < 2; ++n)
#pragma unroll
                    for (int e = 0; e < 4; ++e) { a0[4 * n + e] = acc[ai][0][m][n][e] * r; a1[4 * n + e] = acc[ai][1][m][n][e] * r; }
                if (pn < 6) {
                    const int idx0 = 32 * (wc & 1) + 8 * fq; const int head = 2 * pn + (wc >> 1); const size_t qi = ((size_t)row * NH + head) * HD + idx0;
                    u32x4 r1, r2; r1.x = cvtpk(a0[0], a0[1]); r1.y = cvtpk(a0[2], a0[3]); r1.z = cvtpk(a0[4], a0[5]); r1.w = cvtpk(a0[6], a0[7]);
                    r2.x = cvtpk(a1[0], a1[1]); r2.y = cvtpk(a1[2], a1[3]); r2.z = cvtpk(a1[4], a1[5]); r2.w = cvtpk(a1[6], a1[7]);
                    *(u32x4*)(QRAW + qi) = r1; *(u32x4*)(QRAW + qi + 64) = r2;
                } else if (pn < 9) {
                    const int idx0 = 32 * (wc & 1) + 8 * fq;
                    float o1[8], o2[8]; const float sf = (float)s;
#pragma unroll
                    for (int j = 0; j < 8; ++j) {
                        const float fr = __builtin_amdgcn_fractf(sf * invr[j]); const float cc = __builtin_amdgcn_cosf(fr), sn = __builtin_amdgcn_sinf(fr);
                        o1[j] = a0[j] * cc - a1[j] * sn; o2[j] = a1[j] * cc + a0[j] * sn; }
                    { const int rh = 2 * (pn - 6) + (wc >> 1); unsigned char* dst = (unsigned char*)(rh < 3 ? KS : KW); const int kvh = rh < 3 ? rh : rh - 3;
                        const size_t ki = (((size_t)bb * NKV + kvh) * SEQ + s) * HD + idx0;
                        *(u32x2*)(dst + ki) = pk8_fp8(o1); *(u32x2*)(dst + ki + 64) = pk8_fp8(o2); }
                } else if (pn < 15) {
                    u32x4 w0, w1; w0.x = cvtpk(a0[0], a0[1]); w0.y = cvtpk(a0[2], a0[3]); w0.z = cvtpk(a0[4], a0[5]); w0.w = cvtpk(a0[6], a0[7]);
                    w1.x = cvtpk(a1[0], a1[1]); w1.y = cvtpk(a1[2], a1[3]); w1.z = cvtpk(a1[4], a1[5]); w1.w = cvtpk(a1[6], a1[7]);
                    const int col = 32 * wc + 8 * fq;
#pragma unroll
                    for (int bj = 0; bj < 2; ++bj) { const int ph = 2 * (pn - 9) + bj, tn = ph / 3, kvh = ph % 3;
                        bf16_t* dst = tn == 0 ? KC : (tn == 1 ? VC : (tn == 2 ? VS : VW));
                        *(u32x4*)(dst + (((size_t)bb * NKV + kvh) * SEQ + s) * HD + col) = bj ? w1 : w0; }
                } else if (pn < 19) {
                    float o[8];
#pragma unroll
                    for (int j = 0; j < 8; ++j) o[j] = a0[j] * sigmoidf_(a1[j]);
                    u32x4 w; w.x = cvtpk(o[0], o[1]); w.y = cvtpk(o[2], o[3]); w.z = cvtpk(o[4], o[5]); w.w = cvtpk(o[6], o[7]);
                    *(u32x4*)(U + (size_t)row * CCH + 128 * (pn - 15) + 32 * wc + 8 * fq) = w;
                } else {
                    const int col = 32 * wc + 8 * fq;
                    if (col < GLD) { f32x4 g0, g1;
#pragma unroll
                        for (int j = 0; j < 4; ++j) { g0[j] = sigmoidf_(a0[j]); g1[j] = sigmoidf_(a0[4 + j]); }
                        *(f32x4*)(G + (size_t)row * GLD + col) = g0; *(f32x4*)(G + (size_t)row * GLD + col + 4) = g1; }
                }
            }
    }
};
}

namespace att {
constexpr int SHM_K = 16384, SHM_V = 16384;
constexpr int L_V = 0, L_K = 32768, L_WS = 65536, L_IMP = 67584, L_OACC = 67584, L_SEL = 133120;
constexpr float SCALE = 0.08838834764831845f;
constexpr float THR = 5.5f;
#define KSWZ(row, colB) ((row) * 256 + ((colB) ^ (((row) & 7) << 4)))
__device__ __forceinline__ int v_st(int k, int c) { const int kk = (k & ~0xC) | ((k & 4) << 1) | ((k & 8) >> 1); return ((kk >> 3) * 4 + (c >> 5)) * 512 + ((kk & 7) * 32 + (c & 31)) * 2; }
__device__ __forceinline__ int v_rd_base(int lane) { return ((lane & 3) << 3) | (((lane >> 2) & 3) << 6) | (((lane >> 4) & 1) << 5) | (((lane >> 5) & 1) << 8); }
constexpr int v_rd_off(int d0, int ks, int half) { return d0 * 512 + ks * 4096 + half * 2048; }
__device__ __forceinline__ int crow(int r, int hi) { return (r & 3) + 8 * (r >> 2) + 4 * hi; }

__device__ __forceinline__ void mask_tile(f32x16& p0, f32x16& p1, int dq, unsigned W) {
    const float NEG = -__builtin_inff();
#pragma unroll
    for (int r = 0; r < 16; ++r) {
        const int c = (r & 3) + 8 * (r >> 2);
        if ((unsigned)(dq - c) >= W) p0[r] = NEG;
        if ((unsigned)(dq - c - 32) >= W) p1[r] = NEG;
    }
}
__device__ __forceinline__ void partialSM(f32x16& p0, f32x16& p1, float& m_reg, float& mn, float& alpha, bool sel = true) {
    float pmax = p0[0];
#pragma unroll
    for (int r = 1; r < 16; ++r) pmax = fmaxf(pmax, p0[r]);
#pragma unroll
    for (int r = 0; r < 16; ++r) pmax = fmaxf(pmax, p1[r]);
    { auto rr = __builtin_amdgcn_permlane32_swap(__float_as_uint(pmax), __float_as_uint(pmax), false, false);
      pmax = fmaxf(__uint_as_float(rr[0]), __uint_as_float(rr[1])); }
    constexpr float C2 = 1.4426950408889634f * SCALE;
    pmax = sel ? pmax : -__builtin_inff();
    if (__builtin_expect(__all((pmax - m_reg) * SCALE <= THR), 1)) { mn = m_reg; alpha = 1.f; }
    else { mn = fmaxf(m_reg, pmax); alpha = __builtin_amdgcn_exp2f((m_reg - mn) * C2); m_reg = mn; }
    const float mnL = sel ? -mn * C2 : -__builtin_inff();
#pragma unroll
    for (int r = 0; r < 16; ++r) p0[r] = fmaf(p0[r], C2, mnL);
#pragma unroll
    for (int r = 0; r < 16; ++r) p1[r] = fmaf(p1[r], C2, mnL);
#pragma unroll
    for (int r = 0; r < 16; ++r) p0[r] = __builtin_amdgcn_exp2f(p0[r]);
}
#define PK4(P, B_, OUT) do { unsigned a0 = cvtpk(P[B_+0], P[B_+1]), a1 = cvtpk(P[B_+2], P[B_+3]);                          \
        unsigned b0 = cvtpk(P[B_+4], P[B_+5]), b1 = cvtpk(P[B_+6], P[B_+7]);                                             \
        auto r0 = __builtin_amdgcn_permlane32_swap(a0, b0, false, false); auto r1 = __builtin_amdgcn_permlane32_swap(a1, b1, false, false); \
        u32x4 w = {r0[0], r1[0], r0[1], r1[1]}; OUT = *reinterpret_cast<bf16x8*>(&w); } while (0)
__device__ __forceinline__ void finishSM(f32x16& p0, f32x16& p1, float alpha, float& l_reg, bf16x8& pa0, bf16x8& pa1, bf16x8& pa2, bf16x8& pa3) {
#pragma unroll
    for (int r = 0; r < 16; ++r) p1[r] = __builtin_amdgcn_exp2f(p1[r]);
    float ps = 0;
#pragma unroll
    for (int r = 0; r < 16; ++r) ps += p0[r];
#pragma unroll
    for (int r = 0; r < 16; ++r) ps += p1[r];
    { auto rr = __builtin_amdgcn_permlane32_swap(__float_as_uint(ps), __float_as_uint(ps), false, false);
      ps = __uint_as_float(rr[0]) + __uint_as_float(rr[1]); }
    l_reg = l_reg * alpha + ps;
    PK4(p0, 0, pa0); PK4(p0, 8, pa1); PK4(p1, 0, pa2); PK4(p1, 8, pa3);
}
__device__ __forceinline__ void finishStats(f32x16& p0, f32x16& p1, float alpha, float& l_reg) {
#pragma unroll
    for (int r = 0; r < 16; ++r) p1[r] = __builtin_amdgcn_exp2f(p1[r]);
    float ps = 0;
#pragma unroll
    for (int r = 0; r < 16; ++r) ps += p0[r];
#pragma unroll
    for (int r = 0; r < 16; ++r) ps += p1[r];
    { auto rr = __builtin_amdgcn_permlane32_swap(__float_as_uint(ps), __float_as_uint(ps), false, false);
      ps = __uint_as_float(rr[0]) + __uint_as_float(rr[1]); }
    l_reg = l_reg * alpha + ps;
}
template <int KB>
__device__ __forceinline__ void qkt(f32x16& p0, f32x16& p1, LAS const char* K_lds, int r32, int hi, const bf16x8* qr) {
    p0 = f32x16{}; p1 = f32x16{};
    asm volatile("" : "+v"(r32));
    unsigned kb[4];
#pragma unroll
    for (int dd = 0; dd < 4; ++dd) kb[dd] = (unsigned)(uintptr_t)(K_lds + KB * SHM_K + KSWZ(r32, (dd * 16 + hi * 8) * 2));
#define KRD(dst, a, off) asm volatile("ds_read_b128 %0, %1 offset:%2" : "=v"(dst) : "v"(a), "i"(off) : "memory")
    bf16x8 f0, g0, f1, g1;
    KRD(f0, kb[0], 0); KRD(g0, kb[0], 8192); KRD(f1, kb[1], 0); KRD(g1, kb[1], 8192);
#define QK_STEP(d0, F, G, WAITN) do { asm volatile("s_waitcnt lgkmcnt(" #WAITN ")" ::: "memory"); SBAR(); \
        p0 = __builtin_amdgcn_mfma_f32_32x32x16_bf16(F, qr[d0], p0, 0, 0, 0); p1 = __builtin_amdgcn_mfma_f32_32x32x16_bf16(G, qr[d0], p1, 0, 0, 0); SBAR(); \
        if ((d0) + 2 < 8) { KRD(F, kb[((d0) + 2) & 3], (((d0) + 2) >> 2) * 128); KRD(G, kb[((d0) + 2) & 3], (((d0) + 2) >> 2) * 128 + 8192); } SBAR(); } while (0)
    QK_STEP(0, f0, g0, 2); QK_STEP(1, f1, g1, 2); QK_STEP(2, f0, g0, 2); QK_STEP(3, f1, g1, 2); QK_STEP(4, f0, g0, 2); QK_STEP(5, f1, g1, 2); QK_STEP(6, f0, g0, 2); QK_STEP(7, f1, g1, 0);
#undef QK_STEP
#undef KRD
}
template <int VB>
__device__ __forceinline__ void pv_tile(f32x16* o, int vb0, bf16x8 pa0, bf16x8 pa1, bf16x8 pa2, bf16x8 pa3) {
#define TRRD(dst, off) asm volatile("ds_read_b64_tr_b16 %0, %1 offset:%2" : "=&v"(dst) : "v"(vb0), "i"(off) : "memory")
#define PV_RD(i, L, H) do { constexpr int b_ = VB * SHM_V + v_rd_off((i) >> 2, (i) & 3, 0); TRRD(L, b_); TRRD(H, b_ + 2048); } while (0)
#define PV_MM(i, PA, L, H, WAITN) do { asm volatile("s_waitcnt lgkmcnt(" #WAITN ")" ::: "memory"); SBAR(); \
        o[(i) >> 2] = __builtin_amdgcn_mfma_f32_32x32x16_bf16(PA, (bf16x8){L[0], L[1], L[2], L[3], H[0], H[1], H[2], H[3]}, o[(i) >> 2], 0, 0, 0); SBAR(); \
        if ((i) + 4 < 16) PV_RD((i) + 4, L, H); SBAR(); } while (0)
    s16x4 l0, l1, l2, l3, h0, h1, h2, h3;
    PV_RD(0, l0, h0); PV_RD(1, l1, h1); PV_RD(2, l2, h2); PV_RD(3, l3, h3);
    PV_MM(0, pa0, l0, h0, 6); PV_MM(1, pa1, l1, h1, 6); PV_MM(2, pa2, l2, h2, 6); PV_MM(3, pa3, l3, h3, 6);
    PV_MM(4, pa0, l0, h0, 6); PV_MM(5, pa1, l1, h1, 6); PV_MM(6, pa2, l2, h2, 6); PV_MM(7, pa3, l3, h3, 6);
    PV_MM(8, pa0, l0, h0, 6); PV_MM(9, pa1, l1, h1, 6); PV_MM(10, pa2, l2, h2, 6); PV_MM(11, pa3, l3, h3, 6);
    PV_MM(12, pa0, l0, h0, 6); PV_MM(13, pa1, l1, h1, 4); PV_MM(14, pa2, l2, h2, 2); PV_MM(15, pa3, l3, h3, 0);
#undef PV_MM
#undef PV_RD
#undef TRRD
}

struct AttnP { const bf16_t *QRAW, *KCMP, *VCMP; const unsigned char *KS8, *KW8, *VTS, *VTW; const float* G; void* MIXED; unsigned* ssn; };

#define MFMA16(ACC, A, B) asm volatile("v_mfma_scale_f32_16x16x128_f8f6f4 %0, %1, %2, %0, %3, %3 op_sel_hi:[0,0,0]" : "+v"(ACC) : "v"(A), "v"(B), "v"(0x7f7f7f7fu))
#define MFMA16C(D, A, B, C, SA) asm volatile("v_mfma_scale_f32_16x16x128_f8f6f4 %0, %1, %2, %3, %4, %5 op_sel_hi:[0,0,0]" : "=&v"(D) : "v"(A), "v"(B), "v"(C), "v"(SA), "v"(0x7f7f7f7fu))
#define MFMA_DONE() asm volatile("s_nop 11" ::: "memory")
#define MFMA_PRE() asm volatile("s_nop 1" ::: "memory")
#define RD128(dst, a, off) asm volatile("ds_read_b128 %0, %1 offset:%2" : "=v"(dst) : "v"(a), "i"(off) : "memory")
#define LGK(n) asm volatile("s_waitcnt lgkmcnt(" #n ")" ::: "memory")
typedef int i32x8_t __attribute__((ext_vector_type(8)));
typedef int i32x4_t __attribute__((ext_vector_type(4)));
__device__ __forceinline__ i32x8_t cat88(i32x4_t a, i32x4_t b) { return __builtin_shufflevector(a, b, 0, 1, 2, 3, 4, 5, 6, 7); }
template <int CASE>
__device__ __forceinline__ void qk_half(f32x4 (&s0)[4], f32x4 (&s1)[4], const unsigned ka0, const unsigned ka1, const i32x8_t (&Qf)[2], const f32x4 (&cv)[2]) {
    const unsigned sk = 0x7c7c7c7cu;
    i32x4_t a0l, a0h, a1l, a1h;
    RD128(a0l, ka0, 0); RD128(a0h, ka1, 0); RD128(a1l, ka0, 2048); RD128(a1h, ka1, 2048);
#define QK_(m, lo, hi_) do { const i32x8_t K_ = cat88(lo, hi_); if constexpr (CASE & 1) MFMA16C(s0[m], K_, Qf[0], cv[0], sk); if constexpr (CASE & 2) MFMA16C(s1[m], K_, Qf[1], cv[1], sk); } while (0)
    LGK(2); SBAR(); MFMA_PRE(); QK_(0, a0l, a0h); SBAR(); RD128(a0l, ka0, 4096); RD128(a0h, ka1, 4096); LGK(2); SBAR(); QK_(1, a1l, a1h); SBAR(); RD128(a1l, ka0, 6144); RD128(a1h, ka1, 6144);
    LGK(2); SBAR(); QK_(2, a0l, a0h); SBAR(); LGK(0); SBAR(); QK_(3, a1l, a1h); SBAR(); MFMA_DONE();
#undef QK_
}
template <int CASE>
__device__ __forceinline__ void pv_step(f32x4 (&o0)[8], f32x4 (&o1)[8], const unsigned va0, const unsigned va1, const i32x8_t (&P8)[2]) {
    i32x4_t a0l, a0h, a1l, a1h;
#define PV_(db, lo, hi_) do { const i32x8_t V_ = cat88(lo, hi_); if constexpr (CASE & 1) MFMA16(o0[db], V_, P8[0]); if constexpr (CASE & 2) MFMA16(o1[db], V_, P8[1]); } while (0)
    RD128(a0l, va0, 0); RD128(a0h, va1, 0); RD128(a1l, va0, 2048); RD128(a1h, va1, 2048);
    MFMA_PRE();
#pragma unroll
    for (int q = 0; q < 3; ++q) {
        LGK(2); SBAR(); PV_(2 * q, a0l, a0h); SBAR(); RD128(a0l, va0, (2 * q + 2) * 2048); RD128(a0h, va1, (2 * q + 2) * 2048);
        LGK(2); SBAR(); PV_(2 * q + 1, a1l, a1h); SBAR(); RD128(a1l, va0, (2 * q + 3) * 2048); RD128(a1h, va1, (2 * q + 3) * 2048); }
    LGK(2); SBAR(); PV_(6, a0l, a0h); SBAR(); LGK(0); SBAR(); PV_(7, a1l, a1h); SBAR(); MFMA_DONE();
#undef PV_
}
__device__ __forceinline__ void mask16(f32x4 (&s)[4], const int dq, const unsigned W) {
#pragma unroll
    for (int m = 0; m < 4; ++m)
#pragma unroll
        for (int e = 0; e < 4; ++e) if ((unsigned)(dq - 16 * m - e) >= W) s[m][e] = -__builtin_inff();
}
__device__ __forceinline__ float max16(const f32x4 (&s)[4]) {
    float a = fmaxf(fmaxf(s[0][0], s[0][1]), s[0][2]), b = fmaxf(fmaxf(s[0][3], s[1][0]), s[1][1]);
    a = fmaxf(fmaxf(a, s[1][2]), s[1][3]); b = fmaxf(fmaxf(b, s[2][0]), s[2][1]); a = fmaxf(fmaxf(a, s[2][2]), s[2][3]); b = fmaxf(fmaxf(b, s[3][0]), s[3][1]);
    return fmaxf(fmaxf(fmaxf(a, s[3][2]), s[3][3]), b);
}
__device__ __forceinline__ i32x4_t exp_pack16(f32x4 (&s)[4], const bool sel, float& l) {
    float t0, t1, t2, t3;
    asm volatile("v_exp_f32 %4, %4\n\tv_exp_f32 %5, %5\n\tv_exp_f32 %6, %6\n\tv_exp_f32 %7, %7\n\tv_exp_f32 %8, %8\n\tv_exp_f32 %9, %9\n\tv_exp_f32 %10, %10\n\tv_exp_f32 %11, %11\n\t"
                 "v_exp_f32 %12, %12\n\tv_exp_f32 %13, %13\n\tv_exp_f32 %14, %14\n\tv_exp_f32 %15, %15\n\tv_exp_f32 %16, %16\n\tv_exp_f32 %17, %17\n\tv_exp_f32 %18, %18\n\tv_exp_f32 %19, %19\n\t"
                 "v_add_f32 %0, %4, %5\n\tv_add_f32 %1, %6, %7\n\tv_add_f32 %2, %8, %9\n\tv_add_f32 %3, %10, %11\n\t"
                 "v_add_f32 %0, %0, %12\n\tv_add_f32 %1, %1, %13\n\tv_add_f32 %2, %2, %14\n\tv_add_f32 %3, %3, %15\n\t"
                 "v_add_f32 %0, %0, %16\n\tv_add_f32 %1, %1, %17\n\tv_add_f32 %2, %2, %18\n\tv_add_f32 %3, %3, %19\n\t"
                 "v_add_f32 %0, %0, %1\n\tv_add_f32 %2, %2, %3\n\tv_add_f32 %0, %0, %2"
                 : "=&v"(t0), "=&v"(t1), "=&v"(t2), "=&v"(t3),
                   "+v"(s[0][0]), "+v"(s[0][1]), "+v"(s[0][2]), "+v"(s[0][3]), "+v"(s[1][0]), "+v"(s[1][1]), "+v"(s[1][2]), "+v"(s[1][3]),
                   "+v"(s[2][0]), "+v"(s[2][1]), "+v"(s[2][2]), "+v"(s[2][3]), "+v"(s[3][0]), "+v"(s[3][1]), "+v"(s[3][2]), "+v"(s[3][3]));
    const float ps = t0;
    l += sel ? ps : 0.f;
    unsigned u0, u1, u2, u3; asm volatile("" : "=v"(u0), "=v"(u1), "=v"(u2), "=v"(u3));
    u0 = __builtin_amdgcn_cvt_pk_fp8_f32(s[0][0], s[0][1], u0, false); u0 = __builtin_amdgcn_cvt_pk_fp8_f32(s[0][2], s[0][3], u0, true);
    u1 = __builtin_amdgcn_cvt_pk_fp8_f32(s[1][0], s[1][1], u1, false); u1 = __builtin_amdgcn_cvt_pk_fp8_f32(s[1][2], s[1][3], u1, true);
    u2 = __builtin_amdgcn_cvt_pk_fp8_f32(s[2][0], s[2][1], u2, false); u2 = __builtin_amdgcn_cvt_pk_fp8_f32(s[2][2], s[2][3], u2, true);
    u3 = __builtin_amdgcn_cvt_pk_fp8_f32(s[3][0], s[3][1], u3, false); u3 = __builtin_amdgcn_cvt_pk_fp8_f32(s[3][2], s[3][3], u3, true);
    return (i32x4_t){sel ? (int)u0 : 0, sel ? (int)u1 : 0, sel ? (int)u2 : 0, sel ? (int)u3 : 0};
}
__device__ __forceinline__ i32x4_t sm_quarter(f32x4 (&s)[4], const bool sel, const bool mk, const int dq, const unsigned W, float& mC, f32x4& cv, float& l, f32x4 (&o)[8], i32x4_t& pprev) {
    constexpr float THR2 = THR * 1.4426950408889634f;
    if (mk) mask16(s, dq, W);
    float pm = max16(s); pm = sel ? pm : -__builtin_inff();
    if (__builtin_expect(!__all(pm <= THR2), 0)) {
        float rm = pm; rm = fmaxf(rm, __shfl_xor(rm, 16)); rm = fmaxf(rm, __shfl_xor(rm, 32));
        const float d = fmaxf(rm, 0.f), alpha = __builtin_amdgcn_exp2f(-d); mC += d; l *= alpha;
#pragma unroll
        for (int m = 0; m < 4; ++m) s[m] -= d;
        cv = (f32x4){-mC, -mC, -mC, -mC};
#pragma unroll
        for (int db = 0; db < 8; ++db) o[db] *= alpha;
#pragma unroll
        for (int m = 0; m < 4; ++m) { const int w = pprev[m];
            unsigned u = __builtin_amdgcn_cvt_pk_fp8_f32(__builtin_amdgcn_cvt_f32_fp8(w, 0) * alpha, __builtin_amdgcn_cvt_f32_fp8(w, 1) * alpha, 0u, false);
            u = __builtin_amdgcn_cvt_pk_fp8_f32(__builtin_amdgcn_cvt_f32_fp8(w, 2) * alpha, __builtin_amdgcn_cvt_f32_fp8(w, 3) * alpha, u, true); pprev[m] = (int)u; }
    }
    return exp_pack16(s, sel, l);
}

__device__ __forceinline__ void attn_unit(const AttnP& P, int b, int g, int i, LAS char* lds, int wid) {
    const int lane = lane_id_(), tid = wid * 64 + lane, r32 = lane & 31, hi = lane >> 5;
    LAS char* V_lds = lds + L_V; LAS char* K_lds = lds + L_K;
    LAS float* ws = (LAS float*)(lds + L_WS) + wid * 64; LAS float* li_l = ws; LAS float* al_l = ws + 32;
    LAS float* impA = (LAS float*)(lds + L_IMP); LAS float* impB = impA + 64 * 128;
    LAS unsigned* oacc = (LAS unsigned*)(lds + L_OACC) + wid * 2048 + lane;
    LAS unsigned* selw = (LAS unsigned*)(lds + L_SEL);
    const int q0 = i * 64, tokl = 8 * wid + (r32 >> 2), head = r32 & 3, tpos = q0 + tokl;
    const size_t tokrow = (size_t)b * SEQ + tpos;
    const int bg = b * NKV + g;
    const unsigned koff0 = (unsigned)((wid * 8 + (lane >> 4)) * 256 + (((lane & 15) ^ (lane >> 4)) << 4)), koff1 = (unsigned)((wid * 8 + 4 + (lane >> 4)) * 256 + (((lane & 15) ^ (4 + (lane >> 4))) << 4));
    unsigned voff0; { const int kk = wid * 8 + ((lane >> 2) & 7), k = (kk & ~0xC) | ((kk & 4) << 1) | ((kk & 8) >> 1); voff0 = (unsigned)(k * 256 + ((lane >> 5) * 32 + (lane & 3) * 8) * 2); }
    const int vb0 = (int)(uintptr_t)V_lds + v_rd_base(lane);
    bf16x8 qr[8];
    f32x16 p0, p1; f32x16 o[4]; float m_reg, l_reg, mn, alpha; bf16x8 pa0, pa1, pa2, pa3;
    constexpr float C2 = 1.4426950408889634f * SCALE;

#define DMA_K(Kp, k0, buf) do { const char* b_ = (const char*)(Kp) + (size_t)(k0) * (HD * 2); LAS unsigned* d_ = (LAS unsigned*)(K_lds + (buf) * SHM_K + wid * 2048); \
        unsigned o0_ = koff0, o1_ = koff1; asm volatile("" : "+v"(o0_), "+v"(o1_)); \
        __builtin_amdgcn_global_load_lds((const unsigned*)(b_ + o0_), d_, 16, 0, 0); __builtin_amdgcn_global_load_lds((const unsigned*)(b_ + o1_), d_ + 256, 16, 0, 0); } while (0)
#define DMA_V(Vp, k0, buf) do { const char* b_ = (const char*)(Vp) + (size_t)(k0) * (HD * 2); LAS unsigned* d_ = (LAS unsigned*)(V_lds + (buf) * SHM_V + wid * 2048); \
        unsigned o0_ = voff0; asm volatile("" : "+v"(o0_)); \
        __builtin_amdgcn_global_load_lds((const unsigned*)(b_ + o0_), d_, 16, 0, 0); __builtin_amdgcn_global_load_lds((const unsigned*)(b_ + o0_ + 128), d_ + 256, 16, 0, 0); } while (0)
#define ABAR() asm volatile("s_waitcnt lgkmcnt(0)\n\ts_barrier" ::: "memory")
#define VMW(n) asm volatile("s_waitcnt vmcnt(" #n ")" ::: "memory")
#define RESC(a) do { if (__any((a) < 1.f)) { if (hi == 0) al_l[r32] = (a); LDS_WAIT();              \
                     _Pragma("unroll") for (int d_ = 0; d_ < 4; ++d_) _Pragma("unroll") for (int r = 0; r < 16; ++r) o[d_][r] *= al_l[crow(r, hi)]; } } while (0)
#define LOADQ(Qp) do { _Pragma("unroll") for (int d0 = 0; d0 < 8; ++d0) qr[d0] = *(const bf16x8*)((Qp) + (tokrow * NH + g * 4 + head) * HD + d0 * 16 + hi * 8); } while (0)

    const bf16_t* Kc = P.KCMP + (size_t)bg * NCP * HD; const bf16_t* Vc = P.VCMP + (size_t)bg * NCP * HD;
    const int ncmp = 4 * i + 3, NTC = (ncmp + 63) >> 6;
    const int tc = tpos >= 31 ? ((tpos - 31) >> 4) : -1;
    LOADQ(P.QRAW);
    m_reg = -1e30f; l_reg = 0.f;
    DMA_K(Kc, 0, 0); VMW(0); ABAR();
    for (int t = 0; t < NTC; ++t) {
        if (t + 1 < NTC) DMA_K(Kc, (t + 1) * 64, (t + 1) & 1);
        qkt<0>(p0, p1, K_lds + (t & 1) * SHM_K, r32, hi, qr);
        if (__any(t * 64 + 63 > tc)) mask_tile(p0, p1, tc - t * 64 - 4 * hi, 0x7fffffffu);
        partialSM(p0, p1, m_reg, mn, alpha); finishStats(p0, p1, alpha, l_reg);
        VMW(0); ABAR();
    }
    const float mL = l_reg > 0.f ? -m_reg * C2 - __builtin_amdgcn_logf(l_reg) : -__builtin_inff();
#pragma unroll
    for (int d = 0; d < 4; ++d) o[d] = f32x16{};
    DMA_K(Kc, 0, 0); DMA_V(Vc, 0, 0); VMW(0); ABAR();
    for (int t = 0; t < NTC; ++t) {
        if (t + 1 < NTC) { DMA_K(Kc, (t + 1) * 64, (t + 1) & 1); DMA_V(Vc, (t + 1) * 64, (t + 1) & 1); }
        qkt<0>(p0, p1, K_lds + (t & 1) * SHM_K, r32, hi, qr);
        if (__any(t * 64 + 63 > tc)) mask_tile(p0, p1, tc - t * 64 - 4 * hi, 0x7fffffffu);
#pragma unroll
        for (int r = 0; r < 16; ++r) { p0[r] = __builtin_amdgcn_exp2f(fmaf(p0[r], C2, mL)); p1[r] = __builtin_amdgcn_exp2f(fmaf(p1[r], C2, mL)); }
        if (i >= 16) {
#pragma unroll
            for (int q = 0; q < 8; ++q) {
                const float x0 = q < 4 ? p0[4 * q] : p1[4 * (q - 4)], x1 = q < 4 ? p0[4 * q + 1] : p1[4 * (q - 4) + 1], x2 = q < 4 ? p0[4 * q + 2] : p1[4 * (q - 4) + 2], x3 = q < 4 ? p0[4 * q + 3] : p1[4 * (q - 4) + 3];
                float av = 2.f * ((x0 + x1) + x2) + x3, bv = x3;
                av += dppf<DPP_X1>(av); av += dppf<DPP_X2>(av); bv += dppf<DPP_X1>(bv); bv += dppf<DPP_X2>(bv);
                const int jb = 16 * t + 2 * (q & 3) + hi + 8 * (q >> 2);
                if (head == 0) { impA[tokl * 128 + jb] = av; impB[tokl * 128 + jb] = bv; } }
        }
        PK4(p0, 0, pa0); PK4(p0, 8, pa1); PK4(p1, 0, pa2); PK4(p1, 8, pa3);
        pv_tile<0>(o, vb0 + (t & 1) * SHM_V, pa0, pa1, pa2, pa3);
        VMW(0); ABAR();
    }
    {
        int tk = tid; asm volatile("" : "+v"(tk));
        const int tl = tk >> 3, sub = tk & 7; unsigned sel = 0u;
        if (i < 16) {
#pragma unroll
            for (int jj = 0; jj < 16; ++jj) if (sub * 16 + jj <= i) sel |= 1u << jj;
        } else {
            unsigned key[16];
            LAS const float* ia = impA + tl * 128 + sub * 16; LAS const float* ib = impB + tl * 128 + sub * 16 - 1;
            float va[16];
#pragma unroll
            for (int jj = 0; jj < 16; ++jj) va[jj] = ia[jj] + ib[jj];
#pragma unroll
            for (int jj = 0; jj < 16; ++jj) { const int j = sub * 16 + jj; const bool valid = (j >= 1) && (j <= i - 2);
                key[jj] = valid ? ((__float_as_uint(va[jj]) & 0xFFFFFF80u) | (unsigned)(127 - j)) : 0u; }
#define TK_CE(a_, b_) do { const unsigned hi_ = key[a_] > key[b_] ? key[a_] : key[b_], lo_ = key[a_] > key[b_] ? key[b_] : key[a_]; key[a_] = hi_; key[b_] = lo_; } while (0)
#pragma unroll
            for (int p = 1; p < 16; p *= 2)
#pragma unroll
                for (int k = p; k >= 1; k /= 2)
#pragma unroll
                    for (int j = k % p; j + k < 16; j += 2 * k)
#pragma unroll
                        for (int i2 = 0; i2 < k; ++i2) if (i2 + j + k < 16 && (i2 + j) / (2 * p) == (i2 + j + k) / (2 * p)) TK_CE(i2 + j, i2 + j + k);
#undef TK_CE
#pragma unroll 1
            for (int round = 0; round < 13; ++round) {
                unsigned gm = key[0]; { unsigned o1 = dppu<DPP_X1>(gm); gm = gm > o1 ? gm : o1; o1 = dppu<DPP_X2>(gm); gm = gm > o1 ? gm : o1; o1 = dppu<DPP_HM>(gm); gm = gm > o1 ? gm : o1; }
                const bool win = key[0] == gm && gm != 0u;
                sel |= win ? 1u << ((127u - (gm & 127u)) & 15u) : 0u;
#pragma unroll
                for (int q = 0; q < 15; ++q) key[q] = win ? key[q + 1] : key[q];
                key[15] = win ? 0u : key[15];
            }
#pragma unroll
            for (int jj = 0; jj < 16; ++jj) { const int j = sub * 16 + jj; if (j == 0 || j == i || j == i - 1) sel |= 1u << jj; }
        }
        __syncthreads();
        ((LAS unsigned short*)selw)[tl * 8 + sub] = (unsigned short)sel;
    }
    {
        if (hi == 0) li_l[r32] = P.G[tokrow * GLD + (g * 4 + head) * 3 + 0];
        LDS_WAIT(); SBAR();
        LAS char* img = lds + L_OACC + wid * 8192;
#pragma unroll
        for (int r = 0; r < 16; ++r) { const int row = crow(r, hi); const float gt = li_l[row]; LAS char* ir = img + row * 256;
#pragma unroll
            for (int d0 = 0; d0 < 4; ++d0) { const int d = d0 * 32 + r32;
                *(LAS unsigned short*)(ir + ((((d >> 2) ^ ((row & 15) << 1))) << 3) + ((d & 3) << 1)) = (unsigned short)cvtpk(o[d0][r] * gt, 0.f); } }
    }
    LDS_WAIT(); __syncthreads();

    {
    int l2 = lane_id_(); asm volatile("" : "+v"(l2));
    const int n = l2 & 15, kg = l2 >> 4;
    i32x8_t Qf[2]; int tposh[2]; constexpr float QSC = 8.f * 1.4426950408889634f * SCALE;
#pragma unroll
    for (int h = 0; h < 2; ++h) {
        tposh[h] = q0 + 8 * wid + 4 * h + (n >> 2);
        const float tp = (float)tposh[h], sgn = kg < 2 ? -1.f : 1.f;
        const bf16_t* qrow = P.QRAW + (((size_t)b * SEQ + tposh[h]) * NH + g * 4 + (n & 3)) * HD;
        const int dA = 32 * kg, dB = dA ^ 64;
#pragma unroll
        for (int c = 0; c < 4; ++c) { const u32x4 xa = *(const u32x4*)(qrow + dA + 8 * c), xb = *(const u32x4*)(qrow + dB + 8 * c); float rr[8];
#pragma unroll
            for (int jj = 0; jj < 8; ++jj) { const float a = (jj & 1) ? bfhi(xa[jj >> 1]) : bflo(xa[jj >> 1]), pb = (jj & 1) ? bfhi(xb[jj >> 1]) : bflo(xb[jj >> 1]);
                const float invr = exp2f(-(float)(32 * (kg & 1) + 8 * c + jj) * (13.287712379549449f / 64.f)) * 0.15915494309189535f;
                const float fr_ = __builtin_amdgcn_fractf(tp * invr); const float cc = __builtin_amdgcn_cosf(fr_), sn = __builtin_amdgcn_sinf(fr_);
                rr[jj] = (a * cc + sgn * (pb * sn)) * QSC; }
            const u32x2 w = pk8_fp8(rr); Qf[h][2 * c] = (int)w.x; Qf[h][2 * c + 1] = (int)w.y; } }
    unsigned kof0, kof1, vof0, vof1, kra0, kra1, vra0, vra1;
    { const int r0 = 16 * wid + (l2 >> 3), r1 = r0 + 8, sl = l2 & 7;
      kof0 = (unsigned)(r0 * 128 + ((sl ^ ((r0 >> 1) & 7)) << 4)); kof1 = (unsigned)(r1 * 128 + ((sl ^ ((r1 >> 1) & 7)) << 4));
      vof0 = (unsigned)(r0 * SEQ + ((sl ^ ((r0 >> 1) & 7)) << 4)); vof1 = (unsigned)(r1 * SEQ + ((sl ^ ((r1 >> 1) & 7)) << 4));
      const int sw = (n >> 1) & 7;
      kra0 = (unsigned)(uintptr_t)K_lds + (unsigned)(n * 128 + (((2 * kg) ^ sw) << 4)); kra1 = (unsigned)(uintptr_t)K_lds + (unsigned)(n * 128 + (((2 * kg + 1) ^ sw) << 4));
      vra0 = (unsigned)(uintptr_t)V_lds + (unsigned)(n * 128 + ((kg ^ sw) << 4)); vra1 = (unsigned)(uintptr_t)V_lds + (unsigned)(n * 128 + (((4 + kg) ^ sw) << 4)); }
#pragma unroll 1
    for (int br = 1; br <= 2; ++br) {
        const unsigned char* Kp = (br == 1 ? P.KS8 : P.KW8) + (size_t)bg * SEQ * HD; const unsigned char* Vp = (br == 1 ? P.VTS : P.VTW) + (size_t)bg * HD * SEQ;
        const int jlo = br == 1 ? 0 : (i > 8 ? i - 8 : 0), NS = (i - jlo + 2) >> 1;
        const unsigned W = br == 1 ? 0x7fffffffu : 512u;
        unsigned sw00 = 0, sw01 = 0, sw02 = 0, sw03 = 0, sw10 = 0, sw11 = 0, sw12 = 0, sw13 = 0;
        if (br == 1) { const int t0 = (8 * wid + (n >> 2)) * 4, t1 = t0 + 16;
            sw00 = selw[t0]; sw01 = selw[t0 + 1]; sw02 = selw[t0 + 2]; sw03 = selw[t0 + 3]; sw10 = selw[t1]; sw11 = selw[t1 + 1]; sw12 = selw[t1 + 2]; sw13 = selw[t1 + 3]; }
#define SELW0(j_) ((((j_) & 64) ? (((j_) & 32) ? sw03 : sw02) : (((j_) & 32) ? sw01 : sw00)) >> ((j_) & 31))
#define SELW1(j_) ((((j_) & 64) ? (((j_) & 32) ? sw13 : sw12) : (((j_) & 32) ? sw11 : sw10)) >> ((j_) & 31))
        f32x4 o0[8], o1[8];
#pragma unroll
        for (int db = 0; db < 8; ++db) { o0[db] = (f32x4){0.f, 0.f, 0.f, 0.f}; o1[db] = (f32x4){0.f, 0.f, 0.f, 0.f}; }
        float mC0 = 0.f, mC1 = 0.f, l0 = 0.f, l1 = 0.f;
        f32x4 cv[2] = {(f32x4){0.f, 0.f, 0.f, 0.f}, (f32x4){0.f, 0.f, 0.f, 0.f}};
        i32x4_t pl0 = {0, 0, 0, 0}, ph0 = {0, 0, 0, 0}, pl1 = {0, 0, 0, 0}, ph1 = {0, 0, 0, 0};
        f32x4 sa0[4], sa1[4];
        bool pa0 = false, pa1 = false;
#define DMA_K16(J_) do { const unsigned char* b_ = Kp + (size_t)(jlo + 2 * (J_)) * 64 * HD; LAS unsigned* d_ = (LAS unsigned*)(K_lds + ((J_) & 1) * 16384 + wid * 2048); \
            unsigned o0_ = kof0, o1_ = kof1; asm volatile("" : "+v"(o0_), "+v"(o1_)); \
            __builtin_amdgcn_global_load_lds((const unsigned*)(b_ + o0_), d_, 16, 0, 0); __builtin_amdgcn_global_load_lds((const unsigned*)(b_ + o1_), d_ + 256, 16, 0, 0); } while (0)
#define DMA_V16(J_) do { const unsigned char* b_ = Vp + (size_t)(jlo + 2 * (J_)) * 64; LAS unsigned* d_ = (LAS unsigned*)(V_lds + ((J_) & 1) * 16384 + wid * 2048); \
            unsigned o0_ = vof0, o1_ = vof1; asm volatile("" : "+v"(o0_), "+v"(o1_)); \
            __builtin_amdgcn_global_load_lds((const unsigned*)(b_ + o0_), d_, 16, 0, 0); __builtin_amdgcn_global_load_lds((const unsigned*)(b_ + o1_), d_ + 256, 16, 0, 0); } while (0)
        DMA_K16(0); VMW(0); ABAR();
        if (wid < 4) __builtin_amdgcn_s_setprio(1);
#pragma unroll 1
        for (int J = 0; J <= NS; ++J) {
            if (J < NS) DMA_V16(J);
            if (J + 1 < NS) DMA_K16(J + 1);
            if (J >= 1 && (pa0 || pa1)) { const unsigned vs_ = (unsigned)(((J - 1) & 1) * 16384); const i32x8_t P8[2] = {cat88(pl0, ph0), cat88(pl1, ph1)};
                pv_step<3>(o0, o1, vra0 + vs_, vra1 + vs_, P8);
                }
            pa0 = false; pa1 = false;
            if (J < NS) {
#pragma unroll
                for (int c = 0; c < 2; ++c) {
                    const int jc = jlo + 2 * J + c;
                    bool s0, s1;
                    if (br == 1) { s0 = SELW0(jc) & 1u; s1 = SELW1(jc) & 1u; } else { s0 = jc <= i; s1 = s0; }
                    const bool a0 = __any(s0), a1 = __any(s1);
                    const unsigned ks_ = (unsigned)((J & 1) * 16384 + c * 8192);
                        if (a0 && a1) qk_half<3>(sa0, sa1, kra0 + ks_, kra1 + ks_, Qf, cv); else if (a0) qk_half<1>(sa0, sa1, kra0 + ks_, kra1 + ks_, Qf, cv); else if (a1) qk_half<2>(sa0, sa1, kra0 + ks_, kra1 + ks_, Qf, cv);
                    const bool mk = (jc == i) || (br == 2 && jc + 8 == i);
                    i32x4_t q0_ = {0, 0, 0, 0}, q1_ = {0, 0, 0, 0};
                    if (a0) q0_ = sm_quarter(sa0, s0, mk, tposh[0] - jc * 64 - 4 * kg, W, mC0, cv[0], l0, o0, pl0);
                    if (a1) q1_ = sm_quarter(sa1, s1, mk, tposh[1] - jc * 64 - 4 * kg, W, mC1, cv[1], l1, o1, pl1);
                    if (c == 0) { pl0 = q0_; pl1 = q1_; } else { ph0 = q0_; ph1 = q1_; }
                    pa0 = pa0 || a0; pa1 = pa1 || a1;
                }
            }
            VMW(0); ABAR();
        }
        __builtin_amdgcn_s_setprio(0);
#undef DMA_K16
#undef DMA_V16
#undef SELW0
#undef SELW1
        const int l3 = lane_id_(), n = l3 & 15, kg = l3 >> 4; const int tposh[2] = {q0 + 8 * wid + (n >> 2), q0 + 8 * wid + 4 + (n >> 2)};
        LAS char* img = lds + L_OACC + wid * 8192;
        l0 += __shfl_xor(l0, 16); l0 += __shfl_xor(l0, 32); l1 += __shfl_xor(l1, 16); l1 += __shfl_xor(l1, 32);
        float gs[2];
        { const float g0_ = P.G[((size_t)b * SEQ + tposh[0]) * GLD + (g * 4 + (n & 3)) * 3 + br], g1_ = P.G[((size_t)b * SEQ + tposh[1]) * GLD + (g * 4 + (n & 3)) * 3 + br];
          gs[0] = l0 > 0.f ? g0_ / l0 : 0.f; gs[1] = l1 > 0.f ? g1_ / l1 : 0.f; }
        if (br == 1) {
#pragma unroll
            for (int h = 0; h < 2; ++h)
#pragma unroll
                for (int db = 0; db < 8; ++db) { LAS u32x2* ip = (LAS u32x2*)(img + (16 * h + n) * 256 + (((4 * db + kg) ^ (2 * n)) << 3)); const u32x2 w = *ip; const f32x4 ov = (h ? o1[db] : o0[db]) * gs[h];
                    *ip = (u32x2){cvtpk(bflo(w.x) + ov[0], bfhi(w.x) + ov[1]), cvtpk(bflo(w.y) + ov[2], bfhi(w.y) + ov[3])}; }
            LDS_WAIT();
        } else {
#pragma unroll
            for (int h = 0; h < 2; ++h) { float sq = 0.f;
                unsigned char* orow = (unsigned char*)P.MIXED + ((size_t)b * SEQ + tposh[h]) * DM + CCH + (g * 4 + (n & 3)) * HD + 4 * kg;
#pragma unroll
                for (int db = 0; db < 8; ++db) { const u32x2 w = *(LAS const u32x2*)(img + (16 * h + n) * 256 + (((4 * db + kg) ^ (2 * n)) << 3)); const f32x4 ov = (h ? o1[db] : o0[db]) * gs[h];
                    const float v0 = bflo(w.x) + ov[0], v1 = bfhi(w.x) + ov[1], v2 = bflo(w.y) + ov[2], v3 = bfhi(w.y) + ov[3];
                    sq += (v0 * v0 + v1 * v1) + (v2 * v2 + v3 * v3);
                    if constexpr (OUT_FP8) { unsigned w8 = __builtin_amdgcn_cvt_pk_fp8_f32(clamp448(v0 * A8N), clamp448(v1 * A8N), 0u, false); w8 = __builtin_amdgcn_cvt_pk_fp8_f32(clamp448(v2 * A8N), clamp448(v3 * A8N), w8, true);
                        *(unsigned*)(orow + 16 * db) = w8; }
                    else { *(u32x2*)((bf16_t*)P.MIXED + ((size_t)b * SEQ + tposh[h]) * DM + CCH + (g * 4 + (n & 3)) * HD + 16 * db + 4 * kg) = (u32x2){cvtpk(v0, v1), cvtpk(v2, v3)}; } }
                sq += dppf<DPP_X1>(sq); sq += dppf<DPP_X2>(sq); sq += __shfl_xor(sq, 16); sq += __shfl_xor(sq, 32);
                if ((n & 3) == 0 && kg == 0) atomicAdd(P.ssn + (size_t)b * SEQ + tposh[h], fixu(sq, SSN)); }
        }
    }
    }
    __syncthreads();
#undef DMA_K
#undef DMA_V
#undef ABAR
#undef VMW
#undef RESC
#undef LOADQ
}
#undef PK4
#undef KSWZ
}

#define XB_TMO      128
#define XB_XCNT(j)  (256  + 64 * (j))
#define XB_XSUB(j)  (1280 + 64 * (j))
#define XB_XGEN(j)  (2304 + 64 * (j))
#define XB_TOP      3328
#define XB_TOPGEN   3392
#define XCD_BAR_WORDS 3456
#define XB_SPIN_CAP (1u << 20)
__device__ __forceinline__ unsigned xb_ld(unsigned* p)              { return __hip_atomic_load(p, __ATOMIC_RELAXED, __HIP_MEMORY_SCOPE_AGENT); }
__device__ __forceinline__ unsigned xb_add(unsigned* p, unsigned v) { return __hip_atomic_fetch_add(p, v, __ATOMIC_RELAXED, __HIP_MEMORY_SCOPE_AGENT); }
__device__ __forceinline__ unsigned xb_xcc_id() { return (unsigned)__builtin_amdgcn_s_getreg((3 << 11) | 20) & 0xFu; }
#define XB_SPIN(cond, bar) do { unsigned _sp = 0; while (cond) { __builtin_amdgcn_s_sleep(1); \
    if ((++_sp & 255u) == 0u) { if (xb_ld(&(bar)[XB_TMO])) break; if (_sp > XB_SPIN_CAP) { atomicAdd(&(bar)[XB_TMO], 1u); break; } } } } while (0)
struct XcdBarrier { unsigned* bar; unsigned x; volatile LAS unsigned* st; int wave; };
__device__ __forceinline__ XcdBarrier xcd_barrier_post(unsigned* bar, volatile LAS unsigned* st, int wave) {
    XcdBarrier b; b.bar = bar; b.x = xb_xcc_id(); b.st = st; b.wave = wave;
    if (wave == 0 && lane_id_() == 0) (void)xb_add(&bar[XB_XCNT(b.x)], 1u);
    return b;
}
__device__ __forceinline__ void xcd_barrier_complete(unsigned* bar, unsigned x, unsigned& nloc, unsigned& nx) {
    const unsigned G = gridDim.x * gridDim.y * gridDim.z;
    unsigned sum, cnt, mine, sp = 0u;
    for (;;) {
        sum = 0u; cnt = 0u; mine = 0u;
#pragma unroll
        for (unsigned j = 0; j < 16; ++j) { const unsigned c = xb_ld(&bar[XB_XCNT(j)]); sum += c; cnt += (c > 0u) ? 1u : 0u; mine = (j == x) ? c : mine; }
        if (sum == G) break;
        __builtin_amdgcn_s_sleep(1);
        if ((++sp & 255u) == 0u) { if (xb_ld(&bar[XB_TMO])) break; if (sp > XB_SPIN_CAP) { atomicAdd(&bar[XB_TMO], 1u); break; } }
    }
    nloc = mine > 0u ? mine : 1u; nx = cnt > 0u ? cnt : 1u;
}
__device__ __forceinline__ void xcd_barrier(const XcdBarrier& b) {
    asm volatile("s_waitcnt vmcnt(0)" ::: "memory");
    __syncthreads();
    if (b.wave == 0 && lane_id_() == 0) {
        unsigned* bar = b.bar;
        __builtin_amdgcn_s_waitcnt(0);
        unsigned nloc = b.st[0], nx = b.st[1];
        if (nloc == 0u) { xcd_barrier_complete(bar, b.x, nloc, nx); b.st[0] = nloc; b.st[1] = nx; }
        const unsigned old = xb_add(&bar[XB_XSUB(b.x)], 1u);
        const unsigned gen = old / nloc;
        if (old + 1u == (gen + 1u) * nloc) {
            __builtin_amdgcn_fence(__ATOMIC_RELEASE, "agent");
            asm volatile("s_waitcnt vmcnt(0)" ::: "memory");
            const unsigned og = xb_add(&bar[XB_TOP], 1u);
            const unsigned tg = og / nx;
            if (og + 1u == (tg + 1u) * nx) xb_add(&bar[XB_TOPGEN], 1u);
            else XB_SPIN(xb_ld(&bar[XB_TOPGEN]) == tg, bar);
            __builtin_amdgcn_fence(__ATOMIC_ACQUIRE, "agent");
            xb_add(&bar[XB_XGEN(b.x)], 1u);
            asm volatile("s_waitcnt vmcnt(0)" ::: "memory");
        } else {
            XB_SPIN(xb_ld(&bar[XB_XGEN(b.x)]) == gen, bar);
            __builtin_amdgcn_fence(__ATOMIC_ACQUIRE, "agent");
            asm volatile("s_waitcnt vmcnt(0)" ::: "memory");
        }
    }
    __syncthreads();
}

__device__ __forceinline__ int win_row(int n) {
    if (n < 512) return 256 * (15 + (n >> 7)) + (n & 127);
    if (n < 1024) { const int j = n - 512; return 256 * (15 + (j >> 7)) + 128 + (j & 127); }
    if (n < 2560) { const int j = n - 1024, h = j >> 7, e = j & 127; return 256 * (h >> 1) + 128 * (e >> 6) + 64 * (h & 1) + (e & 63); }
    if (n < 4864) { const int j = n - 2560, blk = j / 384, r = j % 384, h = r >> 7, e = r & 127;
        if (blk == 2 || blk == 4) { const int rh = (blk == 2 ? 0 : 3) + h; return 256 * (6 + (rh >> 1)) + 128 * (e >> 6) + 64 * (rh & 1) + (e & 63); }
        const int ph = (blk == 0 ? 0 : (blk == 1 ? 3 : (blk == 3 ? 6 : 9))) + h; return 256 * (9 + (ph >> 1)) + 128 * (ph & 1) + e; }
    return 256 * 19 + (n - 4864);
}
__device__ __forceinline__ int dest_row(int kind, int n) {
    if (kind == 0) return n;
    if (kind == 1) return ((n >> 7) << 8) + (n & 127);
    if (kind == 2) return ((n >> 7) << 8) + 128 + (n & 127);
    return win_row(n);
}
template <int QM = 0>
__device__ __forceinline__ void transpose_item(const float* W, int K, int N, void* WTv, int kind, const float* gk, float s, int item, int lane, int KP = 0) {
    constexpr bool F8 = QM != 0; constexpr int KI = F8 ? 128 : 64, KL = KI / 8;
    const int nblk = (N + 31) / 32, kb = item / nblk, nb = item % nblk, k0 = KI * kb + KL * (lane >> 3), n0 = 32 * nb + 4 * (lane & 7);
    if (n0 >= N) return;
    f32x4 v[KL];
    const float* src = W + (size_t)k0 * N + n0;
#pragma unroll
    for (int i = 0; i < KL; ++i) v[i] = *(const f32x4*)(src + (size_t)i * N);
    if (gk) {
#pragma unroll
        for (int i = 0; i < KL; i += 4) { const f32x4 g = *(const f32x4*)(gk + k0 + i); v[i] *= g.x; v[i + 1] *= g.y; v[i + 2] *= g.z; v[i + 3] *= g.w; } }
#pragma unroll
    for (int j = 0; j < 4; ++j) { const int dr = dest_row(kind, n0 + j);
        if constexpr (F8) { float a[8], b[8];
#pragma unroll
            for (int i = 0; i < 8; ++i) { a[i] = v[i][j] * s; b[i] = v[8 + i][j] * s; }
            const u32x2 lo = QM == 2 ? pk8_i8(a, 1.f) : pk8_fp8(a), hi = QM == 2 ? pk8_i8(b, 1.f) : pk8_fp8(b);
            *(u32x4*)((unsigned char*)WTv + (size_t)dr * KP + k0) = (u32x4){lo.x, lo.y, hi.x, hi.y}; }
        else { u32x4 o; o.x = cvtpk(v[0][j] * s, v[1][j] * s); o.y = cvtpk(v[2][j] * s, v[3][j] * s); o.z = cvtpk(v[4][j] * s, v[5][j] * s); o.w = cvtpk(v[6][j] * s, v[7][j] * s);
            *(u32x4*)((bf16_t*)WTv + (size_t)dr * K + k0) = o; } }
}

#define CAS __attribute__((address_space(4)))
typedef const float* const CAS* InTab;
struct Frame {
    LAS unsigned char* lds; int wave, vcu, G;
    InTab in; float* out; unsigned char* ws;
};
#define FRESH_IN(F) do { InTab t_ = (F).in; asm volatile("" : "+s"(t_)); (F).in = t_; } while (0)

__device__ __forceinline__ void p0_prologue(Frame& F) {
    const int LN = lane_id_();
    const int gw = F.vcu * NWAVES + F.wave, NGW = F.G * NWAVES;
    unsigned char* ws = F.ws;
    constexpr int I_F = (DM / 128) * (FF / 32), I_D = (FF / 128) * (DM / 32), I_IN = (DM / 128) * ((NIN + 31) / 32), I_O = (DM / (OUT_FP8 ? 128 : 64)) * (DM / 32), I_C = (4096 / 64) * (256 / 32), I_P = (CCH / 64) * (CCH / 32);
    constexpr int NITEMS = 4 * I_F + 2 * I_D + I_IN + I_O + 2 * I_C + I_P;
    for (int it = gw; it < NITEMS; it += NGW) {
        int r = it;
        if (r < I_F) { transpose_item<2>(F.in[2], DM, FF, ws + WS_WGU1, 1, F.in[1], SW8, r, LN, DM); continue; } r -= I_F;
        if (r < I_F) { transpose_item<2>(F.in[3], DM, FF, ws + WS_WGU1, 2, F.in[1], SW8, r, LN, DM); continue; } r -= I_F;
        if (r < I_F) { transpose_item<2>(F.in[22], DM, FF, ws + WS_WGU2, 1, F.in[21], SW8, r, LN, DM); continue; } r -= I_F;
        if (r < I_F) { transpose_item<2>(F.in[23], DM, FF, ws + WS_WGU2, 2, F.in[21], SW8, r, LN, DM); continue; } r -= I_F;
        if (r < I_D) { transpose_item<1>(F.in[4], FF, DM, ws + WS_WD1, 0, nullptr, 0.5f * W8S, r, LN, FFP); continue; } r -= I_D;
        if (r < I_D) { transpose_item<1>(F.in[24], FF, DM, ws + WS_WD2, 0, nullptr, 0.5f * W8S, r, LN, FFP); continue; } r -= I_D;
        if (r < I_IN) { transpose_item<2>(F.in[6], DM, NIN, ws + WS_WIN, 3, F.in[5], SW8, r, LN, DM); continue; } r -= I_IN;
        if (r < I_O) { const int kb = r / (DM / 32);
            if (OUT_FP8) transpose_item<1>(F.in[20], DM, DM, ws + WS_WOUT, 0, kb < 4 ? F.in[18] : F.in[19] - CCH, W8S, r, LN, DM);
            else transpose_item(F.in[20], DM, DM, ws + WS_WOUT, 0, kb < 8 ? F.in[18] : F.in[19] - CCH, 1.f, r, LN); continue; } r -= I_O;
        if (r < I_C) { transpose_item(F.in[9], 4096, 256, ws + WS_WC1, 0, nullptr, 1.f, r, LN); continue; } r -= I_C;
        if (r < I_C) { transpose_item(F.in[11], 4096, 256, (bf16_t*)(ws + WS_WC1) + 256 * 4096, 0, nullptr, 1.f, r, LN); continue; } r -= I_C;
        transpose_item(F.in[17], CCH, CCH, ws + WS_WPW, 0, nullptr, 1.f, r, LN);
    }
    for (int rr = gw; rr < 220; rr += NGW) { u32x4* p = (u32x4*)(ws + WS_WIN + (size_t)(256 * 19 + 36 + rr) * DM);
#pragma unroll
        for (int j = 0; j < 2; ++j) p[LN + 64 * j] = (u32x4){0u, 0u, 0u, 0u}; }
    for (int rr = gw; rr < 2 * 256; rr += NGW) { u32x4* p = (u32x4*)(ws + (rr < 256 ? WS_WGU1 : WS_WGU2) + (size_t)(43 * 256 + (rr & 255)) * DM);
#pragma unroll
        for (int j = 0; j < 2; ++j) p[LN + 64 * j] = (u32x4){0u, 0u, 0u, 0u}; }
    for (int rr = gw; rr < 2 * DM / 8; rr += NGW) { const int which = rr / (DM / 8), r8 = (rr % (DM / 8)) * 8 + (LN >> 3);
        *(u32x4*)(ws + (which ? WS_WD2 : WS_WD1) + (size_t)r8 * FFP + FF + (LN & 7) * 16) = (u32x4){0u, 0u, 0u, 0u}; }
    { const float* x = F.in[0]; unsigned char* XB8 = ws + WS_XB8; unsigned* ss0 = (unsigned*)(ws + WS_SS0); float* rowf = (float*)(ws + WS_ROWF);
      for (int m = gw; m < T; m += NGW) { const f32x4* xr = (const f32x4*)(x + (size_t)m * DM) + 2 * LN; u32x2* o8 = (u32x2*)(XB8 + (size_t)m * DM) + LN; float s = 0.f, am = 0.f;
          f32x4 v[4], w[4];
#pragma unroll
          for (int j = 0; j < 4; ++j) { v[j] = xr[128 * j]; w[j] = xr[128 * j + 1]; }
#pragma unroll
          for (int j = 0; j < 4; ++j) { s += (v[j].x * v[j].x + v[j].y * v[j].y) + (v[j].z * v[j].z + v[j].w * v[j].w) + (w[j].x * w[j].x + w[j].y * w[j].y) + (w[j].z * w[j].z + w[j].w * w[j].w);
              am = fmaxf(fmaxf(fmaxf(am, fmaxf(fabsf(v[j].x), fabsf(v[j].y))), fmaxf(fabsf(v[j].z), fabsf(v[j].w))), fmaxf(fmaxf(fabsf(w[j].x), fabsf(w[j].y)), fmaxf(fabsf(w[j].z), fabsf(w[j].w)))); }
#pragma unroll
          for (int o = 1; o < 64; o <<= 1) am = fmaxf(am, __shfl_xor(am, o));
          am = fmaxf(am, 1e-20f); const float qs = 127.f / am;
#pragma unroll
          for (int j = 0; j < 4; ++j) { const float v8[8] = {v[j].x, v[j].y, v[j].z, v[j].w, w[j].x, w[j].y, w[j].z, w[j].w}; o8[64 * j] = pk8_i8(v8, qs); }
          s = wave_sum(s); if (LN == 0) { ss0[m] = fixu(s, SSX); rowf[m] = am * (1.f / 127.f); } } }
    { float* b1p = (float*)(ws + WS_B1) + 1024;
      for (int o = gw; o < 32; o += NGW) { const int kv = o >> 4, ch = o & 15; const float* pos = F.in[kv ? 8 : 7] + ch * 256; const float* w1 = F.in[kv ? 11 : 9] + (size_t)ch * 256 * 256 + LN * 4;
          f32x4 a = {0.f, 0.f, 0.f, 0.f};
#pragma unroll 8
          for (int k = 0; k < 256; ++k) a += *(const f32x4*)(w1 + (size_t)k * 256) * pos[k];
          *(f32x4*)(b1p + o * 256 + LN * 4) = a; } }
}

__device__ __forceinline__ void conv_phase(Frame& F) {
    const int LN = lane_id_(); const int TID = F.wave * 64 + LN;
    const bf16_t* U = (const bf16_t*)(F.ws + WS_U); bf16_t* S1 = (bf16_t*)(F.ws + WS_S1);
    const float* dw = F.in[13]; const int c = TID;
    float w[31];
#pragma unroll
    for (int k = 0; k < 31; ++k) w[k] = dw[k * CCH + c];
    const float bias = F.in[14][c];
    LAS float* ybuf = (LAS float*)F.lds;
    f32x4 lg0, lg1, lb0, lb1;
    { const float* g = F.in[15] + LN * 8; const float* bb = F.in[16] + LN * 8; lg0 = *(const f32x4*)g; lg1 = *(const f32x4*)(g + 4); lb0 = *(const f32x4*)bb; lb1 = *(const f32x4*)(bb + 4); }
    unsigned short ub[62];
#define CONV_LOAD(tile_) do { const int t0_ = (tile_) * 32, s0_ = t0_ & (SEQ - 1); _Pragma("unroll") for (int j = 0; j < 62; ++j) { const int pos = s0_ - 30 + j; ub[j] = pos >= 0 ? U[(size_t)(t0_ - 30 + j) * CCH + c] : (unsigned short)0; } } while (0)
    if (F.vcu < T / 32) CONV_LOAD(F.vcu);
    for (int tile = F.vcu; tile < T / 32; tile += F.G) {
        const int t0 = tile * 32;
        float u[62];
#pragma unroll
        for (int j = 0; j < 62; ++j) u[j] = bf2f(ub[j]);
#pragma unroll
        for (int tt = 0; tt < 32; ++tt) { float y = bias;
#pragma unroll
            for (int k = 0; k < 31; ++k) y = fmaf(w[k], u[tt + k], y);
            ybuf[tt * CCH + c] = y; }
        if (tile + F.G < T / 32) CONV_LOAD(tile + F.G);
        asm volatile("s_waitcnt lgkmcnt(0)\n\ts_barrier" ::: "memory");
#pragma unroll
        for (int q = 0; q < 4; ++q) { const int tt = F.wave * 4 + q; const LAS float* yr = ybuf + tt * CCH + LN * 8;
            const f32x4 y0 = *(const LAS f32x4*)yr, y1 = *(const LAS f32x4*)(yr + 4);
            float s = (y0.x + y0.y) + (y0.z + y0.w) + (y1.x + y1.y) + (y1.z + y1.w);
            const float mu = wave_sum(s) * (1.f / CCH);
            const f32x4 d0 = y0 - mu, d1 = y1 - mu;
            float s2 = (d0.x * d0.x + d0.y * d0.y) + (d0.z * d0.z + d0.w * d0.w) + (d1.x * d1.x + d1.y * d1.y) + (d1.z * d1.z + d1.w * d1.w);
            const float rstd = 1.0f / sqrtf(wave_sum(s2) * (1.f / CCH) + EPS);
            const f32x4 z0 = d0 * rstd * lg0 + lb0, z1 = d1 * rstd * lg1 + lb1;
            u32x4 o; o.x = cvtpk(siluf_(z0.x), siluf_(z0.y)); o.y = cvtpk(siluf_(z0.z), siluf_(z0.w)); o.z = cvtpk(siluf_(z1.x), siluf_(z1.y)); o.w = cvtpk(siluf_(z1.z), siluf_(z1.w));
            *(u32x4*)(S1 + (size_t)(t0 + tt) * CCH + LN * 8) = o; }
        asm volatile("s_waitcnt lgkmcnt(0)\n\ts_barrier" ::: "memory");
    }
#undef CONV_LOAD
}

__device__ __forceinline__ void vt8_phase(Frame& F) {
    const int LN = lane_id_(); const int TID = F.wave * 64 + LN; const int kq = TID >> 4, dc = TID & 15;
    const int blk = kq >> 4, kq6 = kq & 15, key0 = 64 * blk + 16 * (kq6 >> 2) + 4 * (kq6 & 3);
    const int col = 64 * blk + 16 * (kq6 & 3) + 4 * (kq6 >> 2);
    LAS unsigned char* img = (LAS unsigned char*)F.lds;
    for (int id = F.vcu; id < 2 * 12 * (SEQ / 128); id += F.G) { const int tn = id / (12 * (SEQ / 128)), r = id % (12 * (SEQ / 128)), bg = r / (SEQ / 128), j = r % (SEQ / 128);
        const bf16_t* src = (const bf16_t*)(F.ws + (tn ? WS_VW : WS_VS)) + ((size_t)bg * SEQ + 128 * j + key0) * HD + 8 * dc;
        u32x4 x[4];
#pragma unroll
        for (int e = 0; e < 4; ++e) x[e] = *(const u32x4*)(src + (size_t)e * HD);
#pragma unroll
        for (int i = 0; i < 8; ++i) { float v[4];
#pragma unroll
            for (int e = 0; e < 4; ++e) v[e] = (i & 1) ? bfhi(x[e][i >> 1]) : bflo(x[e][i >> 1]);
            unsigned w = __builtin_amdgcn_cvt_pk_fp8_f32(clamp448(v[0]), clamp448(v[1]), 0u, false); w = __builtin_amdgcn_cvt_pk_fp8_f32(clamp448(v[2]), clamp448(v[3]), w, true);
            const int d = 8 * dc + i;
            *(LAS unsigned*)(img + d * 128 + ((((col >> 4) ^ ((d >> 3) & 7))) << 4) + (col & 12)) = w; }
        asm volatile("s_waitcnt lgkmcnt(0)\n\ts_barrier" ::: "memory");
        unsigned char* dst = F.ws + (tn ? WS_VTW : WS_VTS) + (size_t)bg * HD * SEQ + 128 * j;
#pragma unroll
        for (int q = 0; q < 2; ++q) { const int cj = TID + 512 * q, d = cj >> 3, s = cj & 7;
            *(u32x4*)(dst + (size_t)d * SEQ + ((s ^ ((d >> 3) & 7)) << 4)) = *(LAS const u32x4*)(img + d * 128 + (s << 4)); }
        asm volatile("s_waitcnt lgkmcnt(0)\n\ts_barrier" ::: "memory");
    }
}

__device__ __forceinline__ void cmp2_phase(Frame& F) {
    const int LN = lane_id_();
    const float* Pp = (const float*)(F.ws + WS_CMPP); const float* b1 = (const float*)(F.ws + WS_B1);
    constexpr int RW = 6;
    LAS float* hb = (LAS float*)F.lds + F.wave * (RW * 256);
    for (int grp = F.vcu; grp < (2 * 12 * NCP) / (8 * RW); grp += F.G) {
        const int row0 = (grp * 8 + F.wave) * RW, kv = row0 / (12 * NCP);
#pragma unroll
        for (int r = 0; r < RW; ++r) { const int m = (row0 + r) % (12 * NCP);
            f32x4 h = *(const f32x4*)(b1 + kv * 256 + LN * 4);
#pragma unroll
            for (int ks = 0; ks < 4; ++ks) h += *(const f32x4*)(Pp + ((size_t)(kv * 4 + ks) * (12 * NCP) + m) * 256 + LN * 4);
            h.x = siluf_(h.x); h.y = siluf_(h.y); h.z = siluf_(h.z); h.w = siluf_(h.w);
            *(LAS f32x4*)(hb + r * 256 + LN * 4) = h; }
        LDS_WAIT();
        const float* w2g = F.in[kv ? 12 : 10]; float a0[RW], a1[RW];
        LAS float* wl = (LAS float*)F.lds + 8 * RW * 256;
#pragma unroll
        for (int r = 0; r < RW; ++r) { a0[r] = 0.f; a1[r] = 0.f; }
#pragma unroll 1
        for (int half = 0; half < 2; ++half) {
            asm volatile("s_waitcnt lgkmcnt(0)\n\ts_barrier" ::: "memory");
#pragma unroll
            for (int pc = 0; pc < 8; ++pc) { const int piece = F.wave * 8 + pc;
                __builtin_amdgcn_global_load_lds((const unsigned*)(w2g + half * 16384 + piece * 256 + LN * 4), (LAS unsigned*)(wl + piece * 256), 16, 0, 0); }
            asm volatile("s_waitcnt vmcnt(0)\n\ts_barrier" ::: "memory");
#pragma unroll 2
            for (int k = 0; k < 128; k += 4) {
                const f32x2 w0 = *(const LAS f32x2*)(wl + (k + 0) * HD + LN * 2), w1 = *(const LAS f32x2*)(wl + (k + 1) * HD + LN * 2), w2v = *(const LAS f32x2*)(wl + (k + 2) * HD + LN * 2), w3 = *(const LAS f32x2*)(wl + (k + 3) * HD + LN * 2);
#pragma unroll
                for (int r = 0; r < RW; ++r) { const f32x4 hv = *(const LAS f32x4*)(hb + r * 256 + half * 128 + k);
                    a0[r] = fmaf(hv.x, w0.x, a0[r]); a1[r] = fmaf(hv.x, w0.y, a1[r]); a0[r] = fmaf(hv.y, w1.x, a0[r]); a1[r] = fmaf(hv.y, w1.y, a1[r]);
                    a0[r] = fmaf(hv.z, w2v.x, a0[r]); a1[r] = fmaf(hv.z, w2v.y, a1[r]); a0[r] = fmaf(hv.w, w3.x, a0[r]); a1[r] = fmaf(hv.w, w3.y, a1[r]); } }
        }
        bf16_t* dst = (bf16_t*)(F.ws + (kv ? WS_VCMP : WS_KCMP));
#pragma unroll
        for (int r = 0; r < RW; ++r) { const int m = (row0 + r) % (12 * NCP); const bool last = (m & (NCP - 1)) == NCP - 1;
            *(unsigned*)(dst + (size_t)m * HD + LN * 2) = last ? 0u : cvtpk(a0[r], a1[r]); }
        LDS_WAIT();
    }
}

__device__ __forceinline__ void final_phase(Frame& F) {
    const int LN = lane_id_();
    const unsigned* ss3 = (const unsigned*)(F.ws + WS_SS3); const float* gf = F.in[25]; const bf16_t* XB = (const bf16_t*)(F.ws + WS_XB);
    const int gw = F.vcu * NWAVES + F.wave, NGW = F.G * NWAVES;
    f32x4 g0[4], g1[4];
#pragma unroll
    for (int j = 0; j < 4; ++j) { g0[j] = *((const f32x4*)gf + 2 * (LN + 64 * j)); g1[j] = *((const f32x4*)gf + 2 * (LN + 64 * j) + 1); }
    for (int m = gw; m < T; m += NGW) { const u32x4* xr = (const u32x4*)(XB + (size_t)m * DM) + LN; f32x4* orow = (f32x4*)(F.out + (size_t)m * DM); const float r = rs_from(ss3[m], SSX_INV, 1.f / DM);
#pragma unroll
        for (int j = 0; j < 4; ++j) { const u32x4 w = xr[64 * j];
            orow[2 * (LN + 64 * j)] = (f32x4){bflo(w.x), bfhi(w.x), bflo(w.y), bfhi(w.y)} * r * g0[j]; orow[2 * (LN + 64 * j) + 1] = (f32x4){bflo(w.z), bfhi(w.z), bflo(w.w), bfhi(w.w)} * r * g1[j]; } }
}

constexpr int N_PHASES = 11;
struct Args { const float* in[26]; float* out; unsigned char* ws; int ph_lo, ph_hi; };
__global__ void __launch_bounds__(NWAVES * 64, 2) hymba_fwd(Args args) {
    extern __shared__ __attribute__((aligned(16))) unsigned char lds[];
    Frame F;
    F.lds = (LAS unsigned char*)lds;
    volatile LAS unsigned* MISC = (volatile LAS unsigned*)(F.lds + MISC_OFF);
    F.wave = __builtin_amdgcn_readfirstlane((int)threadIdx.x >> 6);
    F.G = gridDim.x; { const int bx = blockIdx.x; F.vcu = (F.G % 8 == 0) ? (bx % 8) * (F.G / 8) + bx / 8 : bx; }
    F.in = (InTab)__builtin_amdgcn_kernarg_segment_ptr();
    F.out = args.out; F.ws = args.ws;
    unsigned char* ws = args.ws;
    unsigned* ctl = (unsigned*)(ws + WS_CTL);
    for (int u = F.wave * 64 + lane_id_(); u < (LDS_BYTES - LDSCTL_OFF) / 4; u += NWAVES * 64) ((LAS unsigned*)(F.lds + LDSCTL_OFF))[u] = 0u;
    __syncthreads();
    const int lo = args.ph_lo, hi = args.ph_hi;
    const bool one = (hi - lo) > 1;
    XcdBarrier bar; bar.bar = ctl + CW_BAR; bar.x = 0; bar.st = nullptr; bar.wave = 0;
    if (one) bar = xcd_barrier_post(ctl + CW_BAR, MISC + 8, F.wave);
#ifndef PH_MASK
#define PH_MASK 0x7ff
#endif
#define IN(k) (((PH_MASK >> (k)) & 1) && lo <= (k) && (k) < hi)
#define GRID_BAR(k) do { if (IN(k) && IN((k) + 1)) xcd_barrier(bar); } while (0)
    bf16_t* XB = (bf16_t*)(ws + WS_XB); unsigned char* ACT = ws + WS_ACT; unsigned char* XB8 = ws + WS_XB8;
    unsigned* ss0 = (unsigned*)(ws + WS_SS0); unsigned* ss1 = (unsigned*)(ws + WS_SS1); unsigned* ss2 = (unsigned*)(ws + WS_SS2); unsigned* ss3 = (unsigned*)(ws + WS_SS3);
    unsigned* ssc = (unsigned*)(ws + WS_SSC); unsigned* ssn = (unsigned*)(ws + WS_SSN);

#ifndef PROBE_DUP
#define PROBE_DUP 0
#endif
#define DUP(k) ((PROBE_DUP >> (k)) & 1)
    if (IN(0)) { FRESH_IN(F); if (DUP(0)) { p0_prologue(F); if (one) xcd_barrier(bar); } p0_prologue(F); } GRID_BAR(0);
    if (IN(1)) { pg8::Gemm g{(const bf16_t*)XB8, (const bf16_t*)(ws + WS_WGU1), DM / 2, DM / 2, DM / 2}; pg8::StaticOrder S; S.init(T, 2 * FFP, F.G, (int)blockIdx.x, DM / 2, DM / 2);
        pg8::EpiSwiGLU E{ACT, ss0, (const float*)(ws + WS_ROWF), SW8_INV};
        pg8::gemm_phase<pg8::EpiSwiGLU, pg8::StaticOrder, true, 2>(F.lds, g, S, E, F.wave); } GRID_BAR(1);
    if (IN(2)) { FRESH_IN(F); pg8::Gemm g{(const bf16_t*)ACT, (const bf16_t*)(ws + WS_WD1), FFP / 2, FFP / 2, FFP / 2}; pg8::StaticOrder S; S.init(T, DM, F.G, (int)blockIdx.x, FFP / 2, FFP / 2);
        if (DUP(2)) { pg8::EpiResid<0> E2{F.in[0], XB, nullptr, ss0, nullptr, nullptr}; pg8::gemm_phase<pg8::EpiResid<0>, pg8::StaticOrder, true, 1>(F.lds, g, S, E2, F.wave); if (one) xcd_barrier(bar); }
        pg8::EpiResid<0> E{F.in[0], XB, XB8, ss1, nullptr, nullptr}; pg8::gemm_phase<pg8::EpiResid<0>, pg8::StaticOrder, true, 1>(F.lds, g, S, E, F.wave); } GRID_BAR(2);
    if (IN(3)) { constexpr int KD = DM / 2; pg8::Gemm g{(const bf16_t*)XB8, (const bf16_t*)(ws + WS_WIN), KD, KD, KD}; pg8::StaticOrder S; S.init(T, NWIN, F.G, (int)blockIdx.x, KD, KD);
        pg8::EpiWin E{ss1,
            (bf16_t*)(ws + WS_QRAW), (bf16_t*)(ws + WS_QROT), (bf16_t*)(ws + WS_KC), (bf16_t*)(ws + WS_VC), (bf16_t*)(ws + WS_KS), (bf16_t*)(ws + WS_VS), (bf16_t*)(ws + WS_KW), (bf16_t*)(ws + WS_VW),
            (bf16_t*)(ws + WS_U), (float*)(ws + WS_G)};
        pg8::gemm_phase<pg8::EpiWin, pg8::StaticOrder, true, 2>(F.lds, g, S, E, F.wave); } GRID_BAR(3);
    if (IN(4)) { FRESH_IN(F); if (F.vcu == 0) { const int TID = F.wave * 64 + lane_id_(); const float* b1p = (const float*)(ws + WS_B1) + 1024; float sacc = 0.f;
#pragma unroll
            for (int ch = 0; ch < 16; ++ch) sacc += b1p[((TID >> 8) * 16 + ch) * 256 + (TID & 255)];
            ((float*)(ws + WS_B1))[TID] = sacc; }
        conv_phase(F); vt8_phase(F);
        if (DUP(4)) { conv_phase(F); pg8::Gemm g{(const bf16_t*)(ws + WS_KC), (const bf16_t*)(ws + WS_WC1), 1024, 2048, 4096}; pg8::CmpOrder S{F.G, (int)blockIdx.x, (long)(WS_VC - WS_KC)};
            pg8::EpiCmpPart E{(float*)(ws + WS_CMPP)}; pg8::gemm_phase<pg8::EpiCmpPart, pg8::CmpOrder, false, 0>(F.lds, g, S, E, F.wave); if (one) xcd_barrier(bar); }
        pg8::Gemm g{(const bf16_t*)(ws + WS_KC), (const bf16_t*)(ws + WS_WC1), 1024, 2048, 4096}; pg8::CmpOrder S{F.G, (int)blockIdx.x, (long)(WS_VC - WS_KC)};
        pg8::EpiCmpPart E{(float*)(ws + WS_CMPP)}; pg8::gemm_phase<pg8::EpiCmpPart, pg8::CmpOrder, false, 0>(F.lds, g, S, E, F.wave); } GRID_BAR(4);
    if (IN(5)) { FRESH_IN(F); if (DUP(5)) { pg8::Gemm g{(const bf16_t*)(ws + WS_S1), (const bf16_t*)(ws + WS_WPW), CCH, CCH, CCH}; pg8::StaticOrder S; S.init(T, CCH, F.G, (int)blockIdx.x, CCH, CCH);
        pg8::EpiPw E{(void*)(ws + WS_MIXED), ss0}; pg8::gemm_phase<pg8::EpiPw, pg8::StaticOrder, false, 0>(F.lds, g, S, E, F.wave); cmp2_phase(F); if (one) xcd_barrier(bar); }
        { pg8::Gemm g{(const bf16_t*)(ws + WS_S1), (const bf16_t*)(ws + WS_WPW), CCH, CCH, CCH}; pg8::StaticOrder S; S.init(T, CCH, F.G, (int)blockIdx.x, CCH, CCH);
        pg8::EpiPw E{(void*)(ws + WS_MIXED), ssc}; pg8::gemm_phase<pg8::EpiPw, pg8::StaticOrder, false, 0>(F.lds, g, S, E, F.wave); }
        cmp2_phase(F); } GRID_BAR(5);
    if (IN(6)) { const att::AttnP P{(const bf16_t*)(ws + WS_QRAW), (const bf16_t*)(ws + WS_KCMP), (const bf16_t*)(ws + WS_VCMP), ws + WS_KS, ws + WS_KW, ws + WS_VTS, ws + WS_VTW,
            (const float*)(ws + WS_G), (void*)(ws + WS_MIXED), ssn};
        if (DUP(6)) { att::AttnP P2 = P; P2.ssn = ss0;
            for (int p = F.vcu; p < 12 * 64; p += F.G) { const int bg = p >> 6, x = p & 63, b = bg / NKV, g = bg % NKV;
                att::attn_unit(P2, b, g, x, (LAS char*)F.lds, F.wave); att::attn_unit(P2, b, g, 127 - x, (LAS char*)F.lds, F.wave); }
            if (one) xcd_barrier(bar); }
        for (int p = F.vcu, k = 0; p < 12 * 64; p += F.G, ++k) { const int bg = p >> 6, x = ((p & 63) + 21 * k) & 63, b = bg / NKV, g = bg % NKV;
            att::attn_unit(P, b, g, x, (LAS char*)F.lds, F.wave); att::attn_unit(P, b, g, 127 - x, (LAS char*)F.lds, F.wave); } } GRID_BAR(6);
    if (IN(7)) { constexpr int KO = OUT_FP8 ? DM / 2 : DM; pg8::Gemm g{(const bf16_t*)(ws + WS_MIXED), (const bf16_t*)(ws + WS_WOUT), KO, KO, KO}; pg8::StaticOrder S; S.init(T, DM, F.G, (int)blockIdx.x, KO, KO);
        pg8::EpiResid<1> E{nullptr, XB, XB8, ss2, ssc, ssn}; pg8::gemm_phase<pg8::EpiResid<1>, pg8::StaticOrder, true, OUT_FP8 ? 1 : 0>(F.lds, g, S, E, F.wave); } GRID_BAR(7);
    if (IN(8)) { pg8::Gemm g{(const bf16_t*)XB8, (const bf16_t*)(ws + WS_WGU2), DM / 2, DM / 2, DM / 2}; pg8::StaticOrder S; S.init(T, 2 * FFP, F.G, (int)blockIdx.x, DM / 2, DM / 2);
        pg8::EpiSwiGLU E{ACT, ss2, nullptr, SW8_INV / SA2}; pg8::gemm_phase<pg8::EpiSwiGLU, pg8::StaticOrder, true, 2>(F.lds, g, S, E, F.wave); } GRID_BAR(8);
    if (IN(9)) { pg8::Gemm g{(const bf16_t*)ACT, (const bf16_t*)(ws + WS_WD2), FFP / 2, FFP / 2, FFP / 2}; pg8::StaticOrder S; S.init(T, DM, F.G, (int)blockIdx.x, FFP / 2, FFP / 2);
        pg8::EpiResid<2> E{nullptr, XB, nullptr, ss3, nullptr, nullptr}; pg8::gemm_phase<pg8::EpiResid<2>, pg8::StaticOrder, true, 1>(F.lds, g, S, E, F.wave); } GRID_BAR(9);
    if (IN(10)) { FRESH_IN(F); final_phase(F); }
#undef IN
#undef GRID_BAR
}

extern "C" void kernel_launch(void* const* d_in, const int* in_sizes, int n_in, void* d_out, int out_size, void* d_ws, size_t ws_size, hipStream_t stream) {
    static int grid = 0;
    if (grid == 0) {
        if (n_in != 26 || in_sizes[0] != T * DM || out_size != T * DM || ws_size < WS_END) { fprintf(stderr, "kernel_launch: unexpected shapes (n_in %d, ws %zu)\n", n_in, ws_size); grid = -1; return; }
        int dev = 0, cus = 0, per_cu = 0;
        if (hipGetDevice(&dev) != hipSuccess || hipDeviceGetAttribute(&cus, hipDeviceAttributeMultiprocessorCount, dev) != hipSuccess) { grid = -1; return; }
        if (hipFuncSetAttribute((const void*)hymba_fwd, hipFuncAttributeMaxDynamicSharedMemorySize, LDS_BYTES) != hipSuccess) { grid = -1; return; }
        if (hipOccupancyMaxActiveBlocksPerMultiprocessor(&per_cu, (const void*)hymba_fwd, NWAVES * 64, LDS_BYTES) != hipSuccess || per_cu < 1) { fprintf(stderr, "kernel_launch: occupancy query says %d\n", per_cu); }
        (void)hipGetLastError();
        grid = cus;
    }
    if (grid < 0) return;
    if (hipMemsetAsync((char*)d_ws + WS_CTL, 0, CTL_ZERO_BYTES, stream) != hipSuccess) return;
    Args a{};
    for (int i = 0; i < 26; ++i) a.in[i] = (const float*)d_in[i];
    a.out = (float*)d_out; a.ws = (unsigned char*)d_ws;
#if MK_N_LAUNCHES == 1
    a.ph_lo = 0; a.ph_hi = N_PHASES;
    hipLaunchKernelGGL(hymba_fwd, dim3(grid), dim3(NWAVES * 64), LDS_BYTES, stream, a);
#else
    for (int p = 0; p < N_PHASES; ++p) { a.ph_lo = p; a.ph_hi = p + 1; hipLaunchKernelGGL(hymba_fwd, dim3(grid), dim3(NWAVES * 64), LDS_BYTES, stream, a); }
#endif
}
```
